# Optimizing an MI355X kernel written in HIP

```python
import math
import jax, jax.numpy as jnp
from jax import lax
import numpy as np

D_MODEL = 1024
BATCH = 2
SEQ = 8192
DEPTH = 1
DEC_BATCH = 128
DEC_SEQ = 4
PAST_LEN = 8192
PAGE_SIZE = 128

NORM_EPS = 1e-6
PLE_DIM = 256
FFN_DIM = ((8 * D_MODEL) // 3 + 127) // 128 * 128
GDN_HEADS = D_MODEL // 256
GDN_DK = 128
GDN_DV = 128
GDN_KEY_DIM = GDN_HEADS * GDN_DK
GDN_VAL_DIM = GDN_HEADS * GDN_DV
CONV_DIM = 2 * GDN_KEY_DIM + GDN_VAL_DIM
CONV_WIDTH = 4
GDN_CHUNK = 64
SWA_HEADS = D_MODEL // 128
SWA_KV_HEADS = SWA_HEADS // 4
SWA_GROUP = SWA_HEADS // SWA_KV_HEADS
SWA_HEAD_DIM = 64
SWA_Q_DIM = SWA_HEADS * SWA_HEAD_DIM
SWA_KV_DIM = SWA_KV_HEADS * SWA_HEAD_DIM
SWA_WINDOW = 128
NUM_BUCKETS = 32
REL_MAX_DISTANCE = 128
MIX_DIM = GDN_VAL_DIM + SWA_Q_DIM
PROJ_SPLITS = (CONV_DIM, GDN_VAL_DIM, GDN_HEADS, GDN_HEADS, SWA_Q_DIM, SWA_KV_DIM, SWA_KV_DIM)
PROJ_DIM = sum(PROJ_SPLITS)

kernel_name = 'hymba_gdn_swa_macaron_step'


def rmsnorm(x, gain):
    x32 = x.astype(jnp.float32)
    y = x32 * lax.rsqrt(jnp.mean(x32 * x32, axis=-1, keepdims=True) + NORM_EPS)
    return (y * gain.astype(jnp.float32)).astype(x.dtype)


def l2norm(t):
    return t * lax.rsqrt(jnp.sum(t * t, axis=-1, keepdims=True) + 1e-6)


def swiglu(h, w_gate, w_up, w_down):
    return (jax.nn.silu(h @ w_gate) * (h @ w_up)) @ w_down


def _chunk(t, n, c):
    return jnp.moveaxis(t.reshape((t.shape[0], n, c) + t.shape[2:]), 3, 1)


def gated_delta_chunked(q, k, v, g, beta, s0):
    B, L, H, DK = q.shape
    DV = v.shape[-1]
    C = min(GDN_CHUNK, L)
    n = -(-L // C)
    pad = n * C - L
    if pad:
        q, k, v, g, beta = [jnp.pad(t, [(0, 0), (0, pad)] + [(0, 0)] * (t.ndim - 2)) for t in (q, k, v, g, beta)]
    q, k, v, g, beta = [_chunk(t, n, C) for t in (q, k, v, g, beta)]
    gc = jnp.cumsum(g, axis=-1)
    idx = jnp.arange(C)
    incl = idx[:, None] >= idx[None, :]
    strict = idx[:, None] > idx[None, :]
    decay = jnp.exp(jnp.where(incl, gc[..., :, None] - gc[..., None, :], -jnp.inf))
    kb = k * beta[..., None]
    lmat = jnp.where(strict, jnp.einsum('bhncd,bhnsd->bhncs', kb, k) * decay, 0.0)
    a_mat = lmat + jnp.eye(C, dtype=lmat.dtype)
    rhs = jnp.concatenate([v * beta[..., None], kb * jnp.exp(gc)[..., None]], axis=-1)
    sol = lax.linalg.triangular_solve(a_mat, rhs, left_side=True, lower=True, unit_diagonal=True)
    u, w = sol[..., :DV], sol[..., DV:]
    qk = jnp.einsum('bhncd,bhnsd->bhncs', q, k) * decay
    q_dec = q * jnp.exp(gc)[..., None]
    k_dec = k * jnp.exp(gc[..., -1:] - gc)[..., None]
    chunk_decay = jnp.exp(gc[..., -1])

    def step(s, xs):
        qk_c, qd_c, kd_c, u_c, w_c, cd_c = xs
        v_new = u_c - jnp.einsum('bhcd,bhde->bhce', w_c, s)
        o_c = jnp.einsum('bhcd,bhde->bhce', qd_c, s) + jnp.einsum('bhcs,bhse->bhce', qk_c, v_new)
        s = s * cd_c[..., None, None] + jnp.einsum('bhcd,bhce->bhde', kd_c, v_new)
        return s, o_c

    xs = tuple(jnp.moveaxis(t, 2, 0) for t in (qk, q_dec, k_dec, u, w, chunk_decay))
    s_final, o = lax.scan(step, s0, xs)
    o = jnp.moveaxis(jnp.moveaxis(o, 0, 2).reshape(B, H, n * C, DV), 1, 2)[:, :L]
    return o, s_final


def gdn_branch(qkv_raw, z, b, a, conv_prev, s0, conv_w, a_log, dt_bias, norm_gain):
    B, L, _ = qkv_raw.shape
    xp = jnp.concatenate([conv_prev.astype(qkv_raw.dtype), qkv_raw], axis=1)
    y = xp[:, 0:L] * conv_w[0]
    for j in range(1, CONV_WIDTH):
        y = y + xp[:, j:j + L] * conv_w[j]
    y = jax.nn.silu(y).astype(jnp.float32)
    q = l2norm(y[..., :GDN_KEY_DIM].reshape(B, L, GDN_HEADS, GDN_DK)) * GDN_DK ** -0.5
    k = l2norm(y[..., GDN_KEY_DIM:2 * GDN_KEY_DIM].reshape(B, L, GDN_HEADS, GDN_DK))
    v = y[..., 2 * GDN_KEY_DIM:].reshape(B, L, GDN_HEADS, GDN_DV)
    beta = jax.nn.sigmoid(b.astype(jnp.float32))
    g = -jnp.exp(a_log.astype(jnp.float32)) * jax.nn.softplus(a.astype(jnp.float32) + dt_bias.astype(jnp.float32))
    o, s_new = gated_delta_chunked(q, k, v, g, beta, s0.astype(jnp.float32))
    o = rmsnorm(o, norm_gain) * jax.nn.silu(z.astype(jnp.float32).reshape(B, L, GDN_HEADS, GDN_DV))
    return o.reshape(B, L, GDN_VAL_DIM).astype(qkv_raw.dtype), xp[:, L:], s_new


def t5_bias(dist, rel_bias):
    d = jnp.maximum(dist, 0)
    exact = NUM_BUCKETS // 2
    log_ratio = jnp.log(jnp.maximum(d, 1).astype(jnp.float32) / exact) / math.log(REL_MAX_DISTANCE / exact)
    large = jnp.minimum(exact + (log_ratio * (NUM_BUCKETS - exact)).astype(jnp.int32), NUM_BUCKETS - 1)
    bucket = jnp.where(d < exact, d, large)
    bias = jnp.moveaxis(rel_bias[bucket].astype(jnp.float32), -1, 0)
    return bias.reshape((SWA_KV_HEADS, SWA_GROUP) + dist.shape)


def sink_softmax(s, sinks):
    sink = jnp.broadcast_to(sinks.reshape(SWA_KV_HEADS, SWA_GROUP, 1, 1).astype(jnp.float32), s.shape[:-1] + (1,))
    return jax.nn.softmax(jnp.concatenate([s, sink], axis=-1), axis=-1)[..., :-1]


def swa_banded(q, k, v, sinks, rel_bias):
    B, L = q.shape[:2]
    W = SWA_WINDOW
    nb = L // W
    qb = q.reshape(B, nb, W, SWA_KV_HEADS, SWA_GROUP, SWA_HEAD_DIM)

    def two_blocks(t):
        tp = jnp.pad(t, [(0, 0), (W, 0), (0, 0), (0, 0)]).reshape(B, nb + 1, W, SWA_KV_HEADS, SWA_HEAD_DIM)
        return jnp.concatenate([tp[:, :-1], tp[:, 1:]], axis=2)

    kb, vb = two_blocks(k), two_blocks(v)
    dist = W + jnp.arange(W)[:, None] - jnp.arange(2 * W)[None, :]
    key_pos = (jnp.arange(nb)[:, None] - 1) * W + jnp.arange(2 * W)[None, :]
    valid = ((dist >= 0) & (dist < W))[None] & (key_pos >= 0)[:, None, :]
    bias = t5_bias(dist, rel_bias)
    s = jnp.einsum('bnqhgd,bnkhd->bnhgqk', qb, kb).astype(jnp.float32) * SWA_HEAD_DIM ** -0.5 + bias
    s = jnp.where(valid[None, :, None, None], s, -jnp.inf)
    p = sink_softmax(s, sinks).astype(v.dtype)
    o = jnp.einsum('bnhgqk,bnkhd->bnqhgd', p, vb)
    return o.reshape(B, L, SWA_Q_DIM)


def swa_buffered(q, k, v, k_buf, v_buf, sinks, rel_bias):
    B, T = q.shape[:2]
    wb = k_buf.shape[1]
    k_all = jnp.concatenate([k_buf.astype(k.dtype), k], axis=1)
    v_all = jnp.concatenate([v_buf.astype(v.dtype), v], axis=1)
    dist = wb + jnp.arange(T)[:, None] - jnp.arange(wb + T)[None, :]
    valid = (dist >= 0) & (dist < SWA_WINDOW)
    bias = t5_bias(dist, rel_bias)
    s = jnp.einsum('bqhgd,bkhd->bhgqk', q, k_all).astype(jnp.float32) * SWA_HEAD_DIM ** -0.5 + bias
    s = jnp.where(valid, s, -jnp.inf)
    p = sink_softmax(s, sinks).astype(v.dtype)
    o = jnp.einsum('bhgqk,bkhd->bqhgd', p, v_all).reshape(B, T, SWA_Q_DIM)
    return o, k_all[:, T:], v_all[:, T:]


def decoder_layer(x, ple, past, lw, rel_bias):
    B, L, _ = x.shape
    h = rmsnorm(x, lw['norm_ffn1_pre'])
    x = x + 0.5 * rmsnorm(swiglu(h, lw['ffn1_w_gate'], lw['ffn1_w_up'], lw['ffn1_w_down']), lw['norm_ffn1_post'])

    h = rmsnorm(x, lw['norm_mix_pre'])
    split_points = np.cumsum(PROJ_SPLITS)[:-1].tolist()
    qkv_raw, z, b, a, q_s, k_s, v_s = jnp.split(h @ lw['w_in'], split_points, axis=-1)
    if past is None:
        conv_prev = jnp.zeros((B, CONV_WIDTH - 1, CONV_DIM), x.dtype)
        s0 = jnp.zeros((B, GDN_HEADS, GDN_DK, GDN_DV), jnp.float32)
    else:
        conv_prev, s0, k_buf, v_buf = past
    gdn_out, conv_new, s_new = gdn_branch(qkv_raw, z, b, a, conv_prev, s0, lw['conv_w'],
                                          lw['gdn_a_log'], lw['gdn_dt_bias'], lw['gdn_norm'])
    q_s = q_s.reshape(B, L, SWA_KV_HEADS, SWA_GROUP, SWA_HEAD_DIM)
    k_s = k_s.reshape(B, L, SWA_KV_HEADS, SWA_HEAD_DIM)
    v_s = v_s.reshape(B, L, SWA_KV_HEADS, SWA_HEAD_DIM)
    if past is None:
        swa_out = swa_banded(q_s, k_s, v_s, lw['swa_sinks'], rel_bias)
        wb = min(SWA_WINDOW, L)
        k_new, v_new = k_s[:, L - wb:], v_s[:, L - wb:]
    else:
        swa_out, k_new, v_new = swa_buffered(q_s, k_s, v_s, k_buf, v_buf, lw['swa_sinks'], rel_bias)
    mix = jnp.concatenate([gdn_out, swa_out], axis=-1) @ lw['w_out']
    x = x + rmsnorm(mix, lw['norm_mix_post'])

    h = rmsnorm(x, lw['norm_ffn2_pre'])
    x = x + 0.5 * rmsnorm(swiglu(h, lw['ffn2_w_gate'], lw['ffn2_w_up'], lw['ffn2_w_down']), lw['norm_ffn2_post'])

    gate = jax.nn.sigmoid(x @ lw['ple_gate'])
    x = x + rmsnorm(gate * (ple @ lw['ple_proj']), lw['norm_ple_post'])
    return x, conv_new, s_new, k_new, v_new


def setup_inputs(seed: int = 0) -> dict:
    key = jax.random.key(seed)
    keys = iter(jax.random.split(key, 48))

    def nrm(shape, scale):
        return scale * jax.random.normal(next(keys), shape, jnp.float32)

    def gain(shape):
        return 1.0 + nrm(shape, 0.05)

    swa_buf = min(SWA_WINDOW, PAST_LEN)
    dt = jnp.exp(jax.random.uniform(next(keys), (DEPTH, GDN_HEADS), jnp.float32, math.log(1e-3), math.log(1e-1)))
    a_init = jax.random.uniform(next(keys), (DEPTH, GDN_HEADS), jnp.float32, 1.0, 16.0)
    return {
        'x_prompt': nrm((BATCH, SEQ, D_MODEL), 1.0),
        'x_sample': nrm((DEC_BATCH, DEC_SEQ, D_MODEL), 1.0),
        'state_conv': nrm((DEPTH, DEC_BATCH, CONV_WIDTH - 1, CONV_DIM), 1.0),
        'state_gdn': nrm((DEPTH, DEC_BATCH, GDN_HEADS, GDN_DK, GDN_DV), 0.5),
        'cache_swa_k': nrm((DEPTH, DEC_BATCH, swa_buf, SWA_KV_HEADS, SWA_HEAD_DIM), 1.0),
        'cache_swa_v': nrm((DEPTH, DEC_BATCH, swa_buf, SWA_KV_HEADS, SWA_HEAD_DIM), 1.0),
        'p_prompt': nrm((DEPTH, BATCH, SEQ, PLE_DIM), 1.0),
        'p_sample': nrm((DEPTH, DEC_BATCH, DEC_SEQ, PLE_DIM), 1.0),
        'rel_bias': nrm((NUM_BUCKETS, SWA_HEADS), 0.5),
        'norm_ffn1_pre': gain((DEPTH, D_MODEL)),
        'norm_ffn1_post': gain((DEPTH, D_MODEL)),
        'ffn1_w_gate': nrm((DEPTH, D_MODEL, FFN_DIM), D_MODEL ** -0.5),
        'ffn1_w_up': nrm((DEPTH, D_MODEL, FFN_DIM), D_MODEL ** -0.5),
        'ffn1_w_down': nrm((DEPTH, FFN_DIM, D_MODEL), FFN_DIM ** -0.5),
        'norm_mix_pre': gain((DEPTH, D_MODEL)),
        'norm_mix_post': gain((DEPTH, D_MODEL)),
        'w_in': nrm((DEPTH, D_MODEL, PROJ_DIM), D_MODEL ** -0.5),
        'conv_w': nrm((DEPTH, CONV_WIDTH, CONV_DIM), CONV_WIDTH ** -0.5),
        'gdn_a_log': jnp.log(a_init),
        'gdn_dt_bias': dt + jnp.log(-jnp.expm1(-dt)),
        'gdn_norm': gain((DEPTH, GDN_DV)),
        'swa_sinks': nrm((DEPTH, SWA_HEADS), 0.5),
        'w_out': nrm((DEPTH, MIX_DIM, D_MODEL), MIX_DIM ** -0.5),
        'norm_ffn2_pre': gain((DEPTH, D_MODEL)),
        'norm_ffn2_post': gain((DEPTH, D_MODEL)),
        'ffn2_w_gate': nrm((DEPTH, D_MODEL, FFN_DIM), D_MODEL ** -0.5),
        'ffn2_w_up': nrm((DEPTH, D_MODEL, FFN_DIM), D_MODEL ** -0.5),
        'ffn2_w_down': nrm((DEPTH, FFN_DIM, D_MODEL), FFN_DIM ** -0.5),
        'ple_gate': nrm((DEPTH, D_MODEL, D_MODEL), D_MODEL ** -0.5),
        'ple_proj': nrm((DEPTH, PLE_DIM, D_MODEL), PLE_DIM ** -0.5),
        'norm_ple_post': gain((DEPTH, D_MODEL)),
    }


def reference(x_prompt, x_sample, state_conv, state_gdn, cache_swa_k, cache_swa_v, p_prompt, p_sample,
              rel_bias, norm_ffn1_pre, norm_ffn1_post, ffn1_w_gate, ffn1_w_up, ffn1_w_down,
              norm_mix_pre, norm_mix_post, w_in, conv_w, gdn_a_log, gdn_dt_bias, gdn_norm, swa_sinks,
              w_out, norm_ffn2_pre, norm_ffn2_post, ffn2_w_gate, ffn2_w_up, ffn2_w_down,
              ple_gate, ple_proj, norm_ple_post):
    yp, ys = x_prompt, x_sample
    conv_p, gdn_p, k_p, v_p = [], [], [], []
    conv_s, gdn_s, k_s, v_s = [], [], [], []
    for i in range(DEPTH):
        lw = dict(norm_ffn1_pre=norm_ffn1_pre[i], norm_ffn1_post=norm_ffn1_post[i],
                  ffn1_w_gate=ffn1_w_gate[i], ffn1_w_up=ffn1_w_up[i], ffn1_w_down=ffn1_w_down[i],
                  norm_mix_pre=norm_mix_pre[i], norm_mix_post=norm_mix_post[i], w_in=w_in[i],
                  conv_w=conv_w[i], gdn_a_log=gdn_a_log[i], gdn_dt_bias=gdn_dt_bias[i],
                  gdn_norm=gdn_norm[i], swa_sinks=swa_sinks[i], w_out=w_out[i],
                  norm_ffn2_pre=norm_ffn2_pre[i], norm_ffn2_post=norm_ffn2_post[i],
                  ffn2_w_gate=ffn2_w_gate[i], ffn2_w_up=ffn2_w_up[i], ffn2_w_down=ffn2_w_down[i],
                  ple_gate=ple_gate[i], ple_proj=ple_proj[i], norm_ple_post=norm_ple_post[i])
        yp, c1, s1, k1, v1 = decoder_layer(yp, p_prompt[i], None, lw, rel_bias)
        ys, c2, s2, k2, v2 = decoder_layer(ys, p_sample[i],
                                           (state_conv[i], state_gdn[i], cache_swa_k[i], cache_swa_v[i]),
                                           lw, rel_bias)
        conv_p.append(c1); gdn_p.append(s1); k_p.append(k1); v_p.append(v1)
        conv_s.append(c2); gdn_s.append(s2); k_s.append(k2); v_s.append(v2)
    return (yp, ys,
            jnp.stack(conv_p), jnp.stack(gdn_p), jnp.stack(k_p), jnp.stack(v_p),
            jnp.stack(conv_s), jnp.stack(gdn_s), jnp.stack(k_s), jnp.stack(v_s))
```

```cpp
#include <hip/hip_runtime.h>
#ifndef DBG_STOP
#define DBG_STOP 99
#endif
#include <cstdio>
#include <cstdint>
namespace pg8 {
#define PG8_LAS __attribute__((address_space(3)))
typedef unsigned short bf16_t;
typedef short bf16x8 __attribute__((ext_vector_type(8)));
typedef float f32x4 __attribute__((ext_vector_type(4)));
typedef unsigned u32x4 __attribute__((ext_vector_type(4)));
constexpr int BM = 256, BK = 64, HALF = 128, HTB = HALF * BK * 2  , STAGE_BYTES = 8 * HTB, NXCD = 8, WGM = 8;

__host__ __device__ __forceinline__ int lds_byte(int r, int c) { const int st = (r >> 4) * 2 + (c >> 5), rr = r & 15, cc = c & 31, ob = rr * 64 + cc * 2; return st * 1024 + (ob ^ (((ob >> 9) & 1) << 5)); }
__host__ __device__ __forceinline__ void stage_rc(int b, int& R, int& C) { const int st = b / 1024, sb = b % 1024, swz = sb ^ (((sb >> 9) & 1) << 5); R = (st >> 1) * 16 + swz / 64; C = (st & 1) * 32 + (swz % 64) / 2; }
__host__ __device__ __forceinline__ int perm32(int rho) { const int n = rho >> 4, i = rho & 15; return 8 * (i >> 2) + 4 * n + (i & 3); }

struct Unit { int pm, pn; };
struct Gemm { const bf16_t* A; const bf16_t* Bt; int M, N, K; };

struct StaticOrder {
    int nM, nN, nwg, G, c;
    __host__ __device__ void init(int M, int N, int G_, int c_) { nM = M / BM; nN = N / BM; nwg = nM * nN; G = G_; c = c_; }
    __host__ __device__ bool next(int i, Unit& u) const {
        const long L = (long)i * G + c; if (L >= nwg) return false;
        int wgid = (int)L; { const int q = nwg / NXCD, r = nwg % NXCD, xcd = wgid % NXCD, off = wgid / NXCD; wgid = (xcd < r ? xcd * (q + 1) : r * (q + 1) + (xcd - r) * q) + off; }
        const int nig = WGM * nN, gid = wgid / nig, fm = gid * WGM, gsz = (nM - fm) < WGM ? (nM - fm) : WGM;
        u.pm = fm + ((wgid % nig) % gsz); u.pn = (wgid % nig) / gsz; return true;
    }
    __device__ __forceinline__ void a_ready(const Unit&) const {}
    __device__ __forceinline__ void done(const Unit&) const {}
};

typedef float f32x2_t __attribute__((ext_vector_type(2))); typedef __bf16 bf16x2_t __attribute__((ext_vector_type(2)));
__device__ __forceinline__ unsigned cvt_pk_bf16(float lo, float hi) { f32x2_t v = {lo, hi}; bf16x2_t b = __builtin_convertvector(v, bf16x2_t); return __builtin_bit_cast(unsigned, b); }
template <int MODE> struct EpiGen {
    static constexpr bool PERM = true, AFTER_DRAIN = false;
    bf16_t* O; int ldc; const bf16_t* aux;
    __device__ __forceinline__ static float silu_f(float g) { return g * __builtin_amdgcn_rcpf(1.0f + __expf(-g)); }
    __device__ __forceinline__ static float sigm_f(float g) { return __builtin_amdgcn_rcpf(1.0f + __expf(-g)); }
    __device__ __forceinline__ void operator()(const f32x4 (&acc)[2][2][4][2], const Unit& u, int wr, int wc, int fr, int fq) const {
        const int row0 = u.pm * BM + wr * 64 + fr;
        if constexpr (MODE == 1) {
            const int col0 = u.pn * HALF + wc * 32 + 8 * fq;
#pragma unroll
            for (int ai = 0; ai < 2; ++ai)
#pragma unroll
                for (int m = 0; m < 4; ++m) { bf16_t* rowp = O + (size_t)(row0 + ai * HALF + m * 16) * ldc + col0;
                    const f32x4 g0 = acc[ai][0][m][0], g1 = acc[ai][0][m][1], u0 = acc[ai][1][m][0], u1 = acc[ai][1][m][1];
                    u32x4 w; w.x = cvt_pk_bf16(silu_f(g0[0]) * u0[0], silu_f(g0[1]) * u0[1]); w.y = cvt_pk_bf16(silu_f(g0[2]) * u0[2], silu_f(g0[3]) * u0[3]);
                    w.z = cvt_pk_bf16(silu_f(g1[0]) * u1[0], silu_f(g1[1]) * u1[1]); w.w = cvt_pk_bf16(silu_f(g1[2]) * u1[2], silu_f(g1[3]) * u1[3]);
                    *(u32x4*)rowp = w; }
        } else {
            const int col0 = u.pn * BM + wc * 32 + 8 * fq;
#pragma unroll
            for (int ai = 0; ai < 2; ++ai)
#pragma unroll
                for (int m = 0; m < 4; ++m) { const size_t off = (size_t)(row0 + ai * HALF + m * 16) * ldc + col0;
#pragma unroll
                    for (int bj = 0; bj < 2; ++bj) { f32x4 v0 = acc[ai][bj][m][0], v1 = acc[ai][bj][m][1];
                        if constexpr (MODE == 2) { v0 = (f32x4){sigm_f(v0[0]), sigm_f(v0[1]), sigm_f(v0[2]), sigm_f(v0[3])}; v1 = (f32x4){sigm_f(v1[0]), sigm_f(v1[1]), sigm_f(v1[2]), sigm_f(v1[3])}; }
                        if constexpr (MODE == 3) { const u32x4 a = *(const u32x4*)(aux + off + bj * HALF);
                            v0[0] *= __uint_as_float(a.x << 16); v0[1] *= __uint_as_float(a.x & 0xffff0000u); v0[2] *= __uint_as_float(a.y << 16); v0[3] *= __uint_as_float(a.y & 0xffff0000u);
                            v1[0] *= __uint_as_float(a.z << 16); v1[1] *= __uint_as_float(a.z & 0xffff0000u); v1[2] *= __uint_as_float(a.w << 16); v1[3] *= __uint_as_float(a.w & 0xffff0000u); }
                        u32x4 w; w.x = cvt_pk_bf16(v0[0], v0[1]); w.y = cvt_pk_bf16(v0[2], v0[3]); w.z = cvt_pk_bf16(v1[0], v1[1]); w.w = cvt_pk_bf16(v1[2], v1[3]);
                        *(u32x4*)(O + off + bj * HALF) = w; } }
        }
    }
};
template <class Epi, class Sched, bool ALIGN_EPI = false, bool SP2 = false>
__device__ __forceinline__ void gemm_phase(PG8_LAS unsigned char* lds, const Gemm g, const Sched& S, const Epi& E) {
    const int tid = threadIdx.x, wid = __builtin_amdgcn_readfirstlane(tid >> 6), lane = tid & 63, wr = wid >> 2, wc = wid & 3, fr = lane & 15, fq = lane >> 4;
    const int K = g.K, nt = K / BK;
    unsigned voffA[2], voffB[2];
#pragma unroll
    for (int i = 0; i < 2; ++i) { int R, C; stage_rc(tid * 16 + i * 8192, R, C); const int Rb = Epi::PERM ? ((R & ~31) + perm32(R & 31)) : R;
        voffA[i] = (unsigned)(R * K + C) * 2u; voffB[i] = (unsigned)(Rb * K + C) * 2u; }
    const size_t kstep = (size_t)(BK * 2);
    const size_t hstep = (size_t)HALF * K * 2;
    const size_t tstep = 2 * hstep;
    const unsigned ldsw = (unsigned)wid * 1024u;
    const int aoff = lds_byte(wr * 64 + fr, fq * 8), boff = lds_byte(wc * 32 + fr, fq * 8);
#define PG8_SA(b, h) (((b) * 2 + (h)) * HTB)
#define PG8_SB(b, h) ((4 + (b) * 2 + (h)) * HTB)
#define PG8_STAGE(bufoff, gbase, voff) do { _Pragma("unroll") for (int _i = 0; _i < 2; ++_i) \
        __builtin_amdgcn_global_load_lds((const unsigned*)((const char*)(gbase) + (voff)[_i]), (PG8_LAS unsigned*)(lds + (bufoff) + ldsw + _i * 8192), 16, 0, 0); } while (0)
#define PG8_LDA(dst, b, h) do { _Pragma("unroll") for (int m = 0; m < 4; ++m) _Pragma("unroll") for (int k = 0; k < 2; ++k) dst[m][k] = *(const PG8_LAS bf16x8*)(lds + PG8_SA(b, h) + aoff + m * 2048 + k * 1024); } while (0)
#define PG8_LDB(dst, b, h) do { _Pragma("unroll") for (int n = 0; n < 2; ++n) _Pragma("unroll") for (int k = 0; k < 2; ++k) dst[n][k] = *(const PG8_LAS bf16x8*)(lds + PG8_SB(b, h) + boff + n * 2048 + k * 1024); } while (0)
#define PG8_MMA(ai, bj, At, Bt) do { __builtin_amdgcn_s_setprio(1); _Pragma("unroll") for (int m = 0; m < 4; ++m) _Pragma("unroll") for (int n = 0; n < 2; ++n) _Pragma("unroll") for (int k = 0; k < 2; ++k) \
        acc[ai][bj][m][n] = __builtin_amdgcn_mfma_f32_16x16x32_bf16(Bt[n][k], At[m][k], acc[ai][bj][m][n], 0, 0, 0); __builtin_amdgcn_s_setprio(0); } while (0)
#define PG8_WAIT_V(n) asm volatile("s_waitcnt vmcnt(" #n ")" ::: "memory")
#define PG8_WAIT_L(n) asm volatile("s_waitcnt lgkmcnt(" #n ")" ::: "memory")
#define PG8_BAR __builtin_amdgcn_s_barrier()
#define PG8_SCHED __builtin_amdgcn_sched_barrier(0)
    Unit cur, nxt; int ui = 0;
    if (!S.next(0, cur)) return;
    f32x4 acc[2][2][4][2];
#pragma unroll
    for (int a = 0; a < 2; ++a)
#pragma unroll
        for (int b = 0; b < 2; ++b)
#pragma unroll
            for (int m = 0; m < 4; ++m)
#pragma unroll
                for (int n = 0; n < 2; ++n) acc[a][b][m][n] = (f32x4){0.f, 0.f, 0.f, 0.f};
    bf16x8 At[4][2], B0[2][2], B1[2][2];
    const char* cA = (const char*)g.A + (size_t)cur.pm * tstep; const char* cB = (const char*)g.Bt + (size_t)cur.pn * tstep;
    S.a_ready(cur);
    if constexpr (SP2) {
        PG8_STAGE(PG8_SB(0, 0), cB, voffB); PG8_STAGE(PG8_SB(0, 1), cB + hstep, voffB); PG8_STAGE(PG8_SA(0, 0), cA, voffA); PG8_STAGE(PG8_SA(0, 1), cA + hstep, voffA);
        if (wr == 1) PG8_BAR;
        PG8_WAIT_V(2); PG8_BAR;
        PG8_STAGE(PG8_SB(1, 0), cB + kstep, voffB); PG8_STAGE(PG8_SA(1, 0), cA + kstep, voffA); PG8_STAGE(PG8_SB(1, 1), cB + hstep + kstep, voffB);
        PG8_WAIT_V(6); PG8_BAR;
    } else {
        PG8_STAGE(PG8_SB(0, 0), cB, voffB); PG8_STAGE(PG8_SA(0, 0), cA, voffA); PG8_STAGE(PG8_SB(0, 1), cB + hstep, voffB); PG8_STAGE(PG8_SA(0, 1), cA + hstep, voffA);
        if (wr == 1) PG8_BAR;
        PG8_WAIT_V(4); PG8_BAR;
        PG8_STAGE(PG8_SB(1, 0), cB + kstep, voffB); PG8_STAGE(PG8_SA(1, 0), cA + kstep, voffA); PG8_STAGE(PG8_SB(1, 1), cB + hstep + kstep, voffB);
        PG8_WAIT_V(6); PG8_BAR;
    }
    for (;;) {
        const bool has_next = S.next(ui + 1, nxt);
        const char* nA = has_next ? (const char*)g.A + (size_t)nxt.pm * tstep : cA; const char* nB = has_next ? (const char*)g.Bt + (size_t)nxt.pn * tstep : cB;
        for (int t = 0; t < nt; t += 2) {
            const bool last = (t == nt - 2);
            const char* a1 = cA + (size_t)(t + 1) * kstep;
            const char* a2 = last ? nA : cA + (size_t)(t + 2) * kstep; const char* b2 = last ? nB : cB + (size_t)(t + 2) * kstep;
            const char* a3 = a2 + kstep; const char* b3 = b2 + kstep;
            if (last && has_next) S.a_ready(nxt);
            if constexpr (SP2) {
            PG8_LDB(B0, 0, 0); PG8_LDB(B1, 0, 1); PG8_SCHED; PG8_LDA(At, 0, 0); PG8_STAGE(PG8_SA(1, 1), a1 + hstep, voffA);
            PG8_WAIT_V(8); PG8_WAIT_L(0); PG8_BAR; PG8_MMA(0, 0, At, B0); PG8_MMA(0, 1, At, B1); PG8_BAR; PG8_SCHED;
            PG8_LDA(At, 0, 1); PG8_STAGE(PG8_SB(0, 0), b2, voffB); PG8_STAGE(PG8_SB(0, 1), b2 + hstep, voffB); PG8_STAGE(PG8_SA(0, 0), a2, voffA);
            PG8_WAIT_V(8); PG8_WAIT_L(0); PG8_BAR; PG8_MMA(1, 0, At, B0); PG8_MMA(1, 1, At, B1); PG8_BAR; PG8_SCHED;
            PG8_LDB(B0, 1, 0); PG8_LDB(B1, 1, 1); PG8_SCHED; PG8_LDA(At, 1, 0); PG8_STAGE(PG8_SA(0, 1), a2 + hstep, voffA);
            PG8_WAIT_V(8); PG8_WAIT_L(0); PG8_BAR; PG8_MMA(0, 0, At, B0); PG8_MMA(0, 1, At, B1); PG8_BAR; PG8_SCHED;
            PG8_LDA(At, 1, 1); PG8_STAGE(PG8_SB(1, 0), b3, voffB); PG8_STAGE(PG8_SB(1, 1), b3 + hstep, voffB); PG8_STAGE(PG8_SA(1, 0), a3, voffA);
            PG8_WAIT_V(8); PG8_WAIT_L(0); PG8_BAR; PG8_MMA(1, 0, At, B0); PG8_MMA(1, 1, At, B1); PG8_BAR; PG8_SCHED;
            } else {
            PG8_LDB(B0, 0, 0); PG8_SCHED; PG8_LDA(At, 0, 0); PG8_STAGE(PG8_SA(1, 1), a1 + hstep, voffA);
            PG8_WAIT_L(8); PG8_BAR; PG8_WAIT_L(0); PG8_MMA(0, 0, At, B0); PG8_BAR; PG8_SCHED;
            PG8_LDB(B1, 0, 1); PG8_STAGE(PG8_SB(0, 0), b2, voffB);
            PG8_BAR; PG8_WAIT_L(0); PG8_MMA(0, 1, At, B1); PG8_BAR;
            PG8_LDA(At, 0, 1); PG8_STAGE(PG8_SA(0, 0), a2, voffA);
            PG8_BAR; PG8_WAIT_L(0); PG8_MMA(1, 0, At, B0); PG8_BAR; PG8_SCHED;
            PG8_STAGE(PG8_SB(0, 1), b2 + hstep, voffB);
            PG8_WAIT_V(6); PG8_BAR; PG8_MMA(1, 1, At, B1); PG8_BAR;
            PG8_LDB(B0, 1, 0); PG8_SCHED; PG8_LDA(At, 1, 0); PG8_STAGE(PG8_SA(0, 1), a2 + hstep, voffA);
            PG8_WAIT_L(8); PG8_BAR; PG8_WAIT_L(0); PG8_MMA(0, 0, At, B0); PG8_BAR; PG8_SCHED;
            PG8_LDB(B1, 1, 1); PG8_STAGE(PG8_SB(1, 0), b3, voffB);
            PG8_BAR; PG8_WAIT_L(0); PG8_MMA(0, 1, At, B1); PG8_BAR;
            PG8_LDA(At, 1, 1); PG8_STAGE(PG8_SA(1, 0), a3, voffA);
            PG8_BAR; PG8_WAIT_L(0); PG8_MMA(1, 0, At, B0); PG8_BAR; PG8_SCHED;
            PG8_STAGE(PG8_SB(1, 1), b3 + hstep, voffB);
            PG8_WAIT_V(6); PG8_BAR; PG8_MMA(1, 1, At, B1); PG8_BAR;
            }
        }
        if constexpr (ALIGN_EPI) { if (wr == 0) PG8_BAR; }
        if constexpr (!Epi::AFTER_DRAIN) { E(acc, cur, wr, wc, fr, fq); S.done(cur); }
        if (!has_next) break;
#pragma unroll
        for (int a = 0; a < 2; ++a)
#pragma unroll
            for (int b = 0; b < 2; ++b)
#pragma unroll
                for (int m = 0; m < 4; ++m)
#pragma unroll
                    for (int n = 0; n < 2; ++n) acc[a][b][m][n] = (f32x4){0.f, 0.f, 0.f, 0.f};
        cur = nxt; cA = nA; cB = nB; ++ui;
        if constexpr (ALIGN_EPI) { if (wr == 1) PG8_BAR; }
    }
    PG8_WAIT_V(0);
    if constexpr (!ALIGN_EPI) { if (wr == 0) PG8_BAR; }
    PG8_BAR;
    if constexpr (Epi::AFTER_DRAIN) { E.fused(acc, cur, wr, wc, fr, fq, lds, wid, lane); S.done(cur); }
#undef PG8_SA
#undef PG8_SB
#undef PG8_STAGE
#undef PG8_LDA
#undef PG8_LDB
#undef PG8_MMA
#undef PG8_WAIT_V
#undef PG8_WAIT_L
#undef PG8_BAR
#undef PG8_SCHED
}
}

#ifndef PG8_SP2
#define PG8_SP2 true
#endif
#ifndef PG8_ALIGN
#define PG8_ALIGN true
#endif
constexpr int NWAVES = 8;
#ifndef MK_N_LAUNCHES
#define MK_N_LAUNCHES 1
#endif
constexpr int N_PHASES = 14;
constexpr int D = 1024, SEQ = 8192, NB = 2, MP = NB * SEQ, DECB = 128, DECT = 4, MS = DECB * DECT, M = MP + MS;
constexpr int FF = 2816, PLE = 256, NIN = 2824, LDC = 3072;
constexpr int C_Q = 0, C_K = 512, C_V = 1024, C_Z = 1536, C_QS = 2048, C_KS = 2560, C_VS = 2688, C_B = 2816, C_A = 2820;
constexpr float EPS = 1e-6f;
constexpr size_t O_Y = 0, O_CONVP = (size_t)M * D, O_GDNP = O_CONVP + 2 * 3 * 1536, O_KP = O_GDNP + 2 * 4 * 128 * 128, O_VP = O_KP + 2 * 128 * 2 * 64,
                 O_CONVS = O_VP + 2 * 128 * 2 * 64, O_GDNS = O_CONVS + (size_t)128 * 3 * 1536, O_KS = O_GDNS + (size_t)128 * 4 * 128 * 128, O_VS = O_KS + (size_t)128 * 128 * 2 * 64,
                 O_END = O_VS + (size_t)128 * 128 * 2 * 64;
constexpr size_t MiB = 1u << 20, KiB = 1024;
constexpr size_t WS_CTL = 0, CTL_ZERO_BYTES = 1 * MiB;
constexpr size_t WS_WGU1 = 1 * MiB, WS_WD1 = 12 * MiB, WS_WIN = 17 * MiB + 512 * KiB, WS_WOUT = 23 * MiB + 512 * KiB, WS_WGU2 = 25 * MiB + 512 * KiB, WS_WD2 = 36 * MiB + 512 * KiB,
                 WS_WPG = 42 * MiB, WS_WPP = 44 * MiB, WS_PBUF = 45 * MiB, WS_HBUF = 54 * MiB, WS_BIG = 87 * MiB, WS_TMP = 186 * MiB, WS_MIXIN = 219 * MiB, WS_END = 252 * MiB;
static_assert(WS_WGU1 + (size_t)2 * FF * D * 2 <= WS_WD1 && WS_WD1 + (size_t)D * FF * 2 <= WS_WIN && WS_WIN + (size_t)LDC * D * 2 <= WS_WOUT && WS_WOUT + (size_t)D * D * 2 <= WS_WGU2 &&
              WS_WGU2 + (size_t)2 * FF * D * 2 <= WS_WD2 && WS_WD2 + (size_t)D * FF * 2 <= WS_WPG && WS_WPG + (size_t)D * D * 2 <= WS_WPP && WS_WPP + (size_t)D * PLE * 2 <= WS_PBUF &&
              WS_PBUF + (size_t)M * PLE * 2 <= WS_HBUF && WS_HBUF + (size_t)M * D * 2 <= WS_BIG && WS_BIG + (size_t)M * LDC * 2 <= WS_TMP && WS_TMP + (size_t)M * D * 2 <= WS_MIXIN &&
              WS_MIXIN + (size_t)M * D * 2 <= WS_END, "d_ws map");
constexpr int CW_TMO = 0, CW_CODE = 1, CW_BAR = 4096;
constexpr int RING_OFF = 0, RING_BYTES = 131072, LDSCTL_OFF = RING_BYTES, MISC_OFF = LDSCTL_OFF + 320, LDS_BYTES = 147456;

#define GAS __attribute__((address_space(1)))
#define LAS __attribute__((address_space(3)))
typedef unsigned short bf16;
typedef unsigned v4u __attribute__((ext_vector_type(4)));
typedef unsigned v2u __attribute__((ext_vector_type(2)));
typedef float f32x4 __attribute__((ext_vector_type(4)));
typedef GAS unsigned gu32;
#define RLX_AGENT __ATOMIC_RELAXED, __HIP_MEMORY_SCOPE_AGENT
#define LDS_WAIT() asm volatile("s_waitcnt lgkmcnt(0)" ::: "memory")
#define VM_WAIT() asm volatile("s_waitcnt vmcnt(0)" ::: "memory")
__device__ __forceinline__ unsigned f2bf(float f) { unsigned u = __builtin_bit_cast(unsigned, f); return (u + 0x7fffu + ((u >> 16) & 1u)) >> 16; }
__device__ __forceinline__ unsigned pk2(float lo, float hi) { return f2bf(lo) | (f2bf(hi) << 16); }
__device__ __forceinline__ float bf2f(bf16 u) { return __uint_as_float((unsigned)u << 16); }
__device__ __forceinline__ float bflo(unsigned u) { return __uint_as_float(u << 16); }
__device__ __forceinline__ float bfhi(unsigned u) { return __uint_as_float(u & 0xffff0000u); }
#define XB_TMO      128
#define XB_XCNT(j)  (256  + 64 * (j))
#define XB_XSUB(j)  (1280 + 64 * (j))
#define XB_XGEN(j)  (2304 + 64 * (j))
#define XB_TOP      3328
#define XB_TOPGEN   3392
#define XCD_BAR_WORDS 3456
#define XB_SPIN_CAP (1u << 27)

__device__ __forceinline__ unsigned xb_ld(unsigned* p)              { return __hip_atomic_load(p, __ATOMIC_RELAXED, __HIP_MEMORY_SCOPE_AGENT); }
__device__ __forceinline__ unsigned xb_add(unsigned* p, unsigned v) { return __hip_atomic_fetch_add(p, v, __ATOMIC_RELAXED, __HIP_MEMORY_SCOPE_AGENT); }
__device__ __forceinline__ unsigned xb_xcc_id() { return (unsigned)__builtin_amdgcn_s_getreg((3 << 11) | 20) & 0xFu; }
#define XB_SPIN(cond, bar) do { unsigned _sp = 0; while (cond) { __builtin_amdgcn_s_sleep(1); \
    if ((++_sp & 255u) == 0u) { if (xb_ld(&(bar)[XB_TMO])) break; if (_sp > XB_SPIN_CAP) { atomicAdd(&(bar)[XB_TMO], 1u); break; } } } } while (0)

struct XcdBarrier {
    unsigned* bar; unsigned x;
    volatile LAS unsigned* st;
};

__device__ __forceinline__ XcdBarrier xcd_barrier_post(unsigned* bar, volatile LAS unsigned* st) {
    XcdBarrier b; b.bar = bar; b.x = xb_xcc_id(); b.st = st;
    if (threadIdx.x == 0) (void)xb_add(&bar[XB_XCNT(b.x)], 1u);
    return b;
}
__device__ __forceinline__ void xcd_barrier_complete(unsigned* bar, unsigned x, unsigned& nloc, unsigned& nx) {
    const unsigned G = gridDim.x * gridDim.y * gridDim.z;
    unsigned sum, cnt, mine, sp = 0u;
    for (;;) {
        sum = 0u; cnt = 0u; mine = 0u;
#pragma unroll
        for (unsigned j = 0; j < 16; ++j) { const unsigned c = xb_ld(&bar[XB_XCNT(j)]); sum += c; cnt += (c > 0u) ? 1u : 0u; mine = (j == x) ? c : mine; }
        if (sum == G) break;
        __builtin_amdgcn_s_sleep(1);
        if ((++sp & 255u) == 0u) { if (xb_ld(&bar[XB_TMO])) break; if (sp > XB_SPIN_CAP) { atomicAdd(&bar[XB_TMO], 1u); break; } }
    }
    nloc = mine > 0u ? mine : 1u; nx = cnt > 0u ? cnt : 1u;
}

__device__ __forceinline__ void xcd_barrier(const XcdBarrier& b) {
    asm volatile("s_waitcnt vmcnt(0)" ::: "memory");
    __syncthreads();
    if (threadIdx.x == 0) {
        unsigned* bar = b.bar;
        __builtin_amdgcn_s_waitcnt(0);
        unsigned nloc = b.st[0], nx = b.st[1];
        if (nloc == 0u) { xcd_barrier_complete(bar, b.x, nloc, nx); b.st[0] = nloc; b.st[1] = nx; }
        const unsigned old = xb_add(&bar[XB_XSUB(b.x)], 1u);
        const unsigned gen = old / nloc;
        if (old + 1u == (gen + 1u) * nloc) {
            __builtin_amdgcn_fence(__ATOMIC_RELEASE, "agent");
            asm volatile("s_waitcnt vmcnt(0)" ::: "memory");
            const unsigned og = xb_add(&bar[XB_TOP], 1u);
            const unsigned tg = og / nx;
            if (og + 1u == (tg + 1u) * nx) xb_add(&bar[XB_TOPGEN], 1u);
            else XB_SPIN(xb_ld(&bar[XB_TOPGEN]) == tg, bar);
            __builtin_amdgcn_fence(__ATOMIC_ACQUIRE, "agent");
            xb_add(&bar[XB_XGEN(b.x)], 1u);
            asm volatile("s_waitcnt vmcnt(0)" ::: "memory");
        } else {
            XB_SPIN(xb_ld(&bar[XB_XGEN(b.x)]) == gen, bar);
            __builtin_amdgcn_fence(__ATOMIC_ACQUIRE, "agent");
            asm volatile("s_waitcnt vmcnt(0)" ::: "memory");
        }
    }
    __syncthreads();
}
struct Args { const float* in[31]; float* out; unsigned char* ws; int ph_lo, ph_hi; };
struct Frame {
    LAS unsigned char* lds;
    volatile LAS unsigned* MISC;
    gu32* ctl;
    int tid, lane, wave;
    int vcu, G;
    float* out; unsigned char* ws;
};
__device__ __forceinline__ float wave_sum(float v) {
#pragma unroll
    for (int o = 1; o < 64; o <<= 1) v += __shfl_xor(v, o);
    return v;
}
__device__ __forceinline__ float wave_max(float v) {
#pragma unroll
    for (int o = 1; o < 64; o <<= 1) v = fmaxf(v, __shfl_xor(v, o));
    return v;
}
__device__ __forceinline__ float silu_f(float g) { return g / (1.0f + __expf(-g)); }
__device__ __forceinline__ float sigm_f(float g) { return 1.0f / (1.0f + __expf(-g)); }
__device__ __forceinline__ const float* xin_row(const float* xp, const float* xs, int m) { return m < MP ? xp + (size_t)m * D : xs + (size_t)(m - MP) * D; }

__device__ __forceinline__ void tr_item(const float* W, int ldw, int n0, int nvalid, int k0, bf16* WT, int ldk, int drow0, LAS float* scr, int lane) {
    const int c = lane & 31;
#pragma unroll 8
    for (int i = 0; i < 32; ++i) { const int kk = 2 * i + (lane >> 5); scr[kk * 33 + c] = (c < nvalid) ? W[(size_t)(k0 + kk) * ldw + n0 + c] : 0.f; }
    LDS_WAIT(); asm volatile("" ::: "memory");
    const int c8 = lane & 7;
#pragma unroll
    for (int j = 0; j < 4; ++j) { const int n = (lane >> 3) + 8 * j; const LAS float* s = scr + (8 * c8) * 33 + n;
        v4u o; o.x = pk2(s[0 * 33], s[1 * 33]); o.y = pk2(s[2 * 33], s[3 * 33]); o.z = pk2(s[4 * 33], s[5 * 33]); o.w = pk2(s[6 * 33], s[7 * 33]);
        if (n < nvalid) *(GAS v4u*)(WT + (size_t)(drow0 + n) * ldk + k0 + 8 * c8) = o; }
    LDS_WAIT(); asm volatile("" ::: "memory");
}
__device__ __forceinline__ void tr_plain(const float* W, int K, int N, bf16* WT, int item, LAS float* scr, int lane) {
    const int nblk = N / 32, kb = item / nblk, nb = item % nblk;
    tr_item(W, N, 32 * nb, 32, 64 * kb, WT, K, 32 * nb, scr, lane);
}
__device__ __forceinline__ void tr_gu(const float* W, bf16* WT, int up, int item, LAS float* scr, int lane) {
    const int nblk = FF / 32, kb = item / nblk, nb = item % nblk, c0 = 32 * nb;
    tr_item(W, FF, c0, 32, 64 * kb, WT, D, 256 * (c0 >> 7) + (c0 & 127) + up * 128, scr, lane);
}
__device__ __forceinline__ void tr_win(const float* W, bf16* WT, int item, LAS float* scr, int lane) {
    const int nblk = 89, kb = item / nblk, nb = item % nblk;
    int n0, nv, d0;
    if (nb < 64) { n0 = 32 * nb; nv = 32; d0 = n0; } else if (nb == 64) { n0 = 2048; nv = 8; d0 = 2816; } else { n0 = 2056 + 32 * (nb - 65); nv = 32; d0 = 2048 + 32 * (nb - 65); }
    tr_item(W, NIN, n0, nv, 64 * kb, WT, D, d0, scr, lane);
}
__device__ __forceinline__ void rms_row_to_bf16(const float* xrow, const float* gain, bf16* orow, int lane) {
    const GAS f32x4* xr = (const GAS f32x4*)xrow + lane; const GAS f32x4* gr = (const GAS f32x4*)gain + lane;
    f32x4 v[4]; float s = 0.f;
#pragma unroll
    for (int j = 0; j < 4; ++j) { v[j] = xr[64 * j]; s += (v[j].x * v[j].x + v[j].y * v[j].y) + (v[j].z * v[j].z + v[j].w * v[j].w); }
    const float r = 1.0f / sqrtf(wave_sum(s) * (1.f / D) + EPS);
    GAS v2u* o8 = (GAS v2u*)orow + lane;
#pragma unroll
    for (int j = 0; j < 4; ++j) { const f32x4 g = gr[64 * j]; v2u o; o.x = pk2(v[j].x * r * g.x, v[j].y * r * g.y); o.y = pk2(v[j].z * r * g.z, v[j].w * r * g.w); o8[64 * j] = o; }
}
__device__ __forceinline__ void p0_prologue(Frame& F, const Args& A) {
    LAS float* scr = (LAS float*)(F.lds + RING_OFF + F.wave * 16384);
    const int gw = F.vcu * NWAVES + F.wave, NGW = F.G * NWAVES;
    bf16* WGU1 = (bf16*)(F.ws + WS_WGU1); bf16* WD1 = (bf16*)(F.ws + WS_WD1); bf16* WIN = (bf16*)(F.ws + WS_WIN); bf16* WOUT = (bf16*)(F.ws + WS_WOUT);
    bf16* WGU2 = (bf16*)(F.ws + WS_WGU2); bf16* WD2 = (bf16*)(F.ws + WS_WD2); bf16* WPG = (bf16*)(F.ws + WS_WPG); bf16* WPP = (bf16*)(F.ws + WS_WPP);
    constexpr int I_GU = (D / 64) * (FF / 32), I_DN = (FF / 64) * (D / 32), I_IN = (D / 64) * 89, I_SQ = (D / 64) * (D / 32), I_PP = (PLE / 64) * (D / 32);
    constexpr int NITEMS = 4 * I_GU + 2 * I_DN + I_IN + 2 * I_SQ + I_PP;
    for (int it = gw; it < NITEMS; it += NGW) {
        int r = it;
        if (r < I_GU) { tr_gu(A.in[11], WGU1, 0, r, scr, F.lane); continue; } r -= I_GU;
        if (r < I_GU) { tr_gu(A.in[12], WGU1, 1, r, scr, F.lane); continue; } r -= I_GU;
        if (r < I_DN) { tr_plain(A.in[13], FF, D, WD1, r, scr, F.lane); continue; } r -= I_DN;
        if (r < I_IN) { tr_win(A.in[16], WIN, r, scr, F.lane); continue; } r -= I_IN;
        if (r < I_SQ) { tr_plain(A.in[22], D, D, WOUT, r, scr, F.lane); continue; } r -= I_SQ;
        if (r < I_GU) { tr_gu(A.in[25], WGU2, 0, r, scr, F.lane); continue; } r -= I_GU;
        if (r < I_GU) { tr_gu(A.in[26], WGU2, 1, r, scr, F.lane); continue; } r -= I_GU;
        if (r < I_DN) { tr_plain(A.in[27], FF, D, WD2, r, scr, F.lane); continue; } r -= I_DN;
        if (r < I_SQ) { tr_plain(A.in[28], D, D, WPG, r, scr, F.lane); continue; } r -= I_SQ;
        tr_plain(A.in[29], PLE, D, WPP, r, scr, F.lane);
    }
    for (int rr = gw; rr < LDC - NIN; rr += NGW) { GAS v4u* o = (GAS v4u*)(WIN + (size_t)(NIN + rr) * D) + F.lane; o[0] = (v4u){0, 0, 0, 0}; o[64] = (v4u){0, 0, 0, 0}; }
    bf16* HB = (bf16*)(F.ws + WS_HBUF); bf16* PB = (bf16*)(F.ws + WS_PBUF);
    for (int m = gw; m < M; m += NGW) {
        rms_row_to_bf16(xin_row(A.in[0], A.in[1], m), A.in[9], HB + (size_t)m * D, F.lane);
        const float* prow = m < MP ? A.in[6] + (size_t)m * PLE : A.in[7] + (size_t)(m - MP) * PLE;
        const f32x4 pv = ((const GAS f32x4*)prow)[F.lane]; v2u o; o.x = pk2(pv.x, pv.y); o.y = pk2(pv.z, pv.w); ((GAS v2u*)(PB + (size_t)m * PLE))[F.lane] = o;
    }
}
template <int HMODE, bool BASE_IN>
__device__ __forceinline__ void resid_pass(Frame& F, const float* xp, const float* xs, const bf16* src, float scale, const float* gpost, const float* g2, bf16* hout) {
    const int gw = F.vcu * NWAVES + F.wave, NGW = F.G * NWAVES;
    for (int m = gw; m < M; m += NGW) {
        const GAS v2u* sr = (const GAS v2u*)(src + (size_t)m * D) + F.lane;
        const float* brow = BASE_IN ? xin_row(xp, xs, m) : F.out + (size_t)m * D;
        const GAS f32x4* br = (const GAS f32x4*)brow + F.lane; const GAS f32x4* gp = (const GAS f32x4*)gpost + F.lane;
        f32x4 v[4], b[4]; float s = 0.f;
#pragma unroll
        for (int j = 0; j < 4; ++j) { const v2u w = sr[64 * j]; v[j] = (f32x4){bflo(w.x), bfhi(w.x), bflo(w.y), bfhi(w.y)}; b[j] = br[64 * j];
            s += (v[j].x * v[j].x + v[j].y * v[j].y) + (v[j].z * v[j].z + v[j].w * v[j].w); }
        const float r = scale / sqrtf(wave_sum(s) * (1.f / D) + EPS);
        float s2 = 0.f;
        GAS f32x4* orow = (GAS f32x4*)(F.out + (size_t)m * D) + F.lane;
#pragma unroll
        for (int j = 0; j < 4; ++j) { const f32x4 g = gp[64 * j]; v[j] = b[j] + v[j] * r * g; orow[64 * j] = v[j];
            s2 += (v[j].x * v[j].x + v[j].y * v[j].y) + (v[j].z * v[j].z + v[j].w * v[j].w); }
        if constexpr (HMODE == 1) {
            const float r2 = 1.0f / sqrtf(wave_sum(s2) * (1.f / D) + EPS); const GAS f32x4* g2r = (const GAS f32x4*)g2 + F.lane; GAS v2u* o8 = (GAS v2u*)(hout + (size_t)m * D) + F.lane;
#pragma unroll
            for (int j = 0; j < 4; ++j) { const f32x4 g = g2r[64 * j]; v2u o; o.x = pk2(v[j].x * r2 * g.x, v[j].y * r2 * g.y); o.y = pk2(v[j].z * r2 * g.z, v[j].w * r2 * g.w); o8[64 * j] = o; }
        } else if constexpr (HMODE == 2) {
            GAS v2u* o8 = (GAS v2u*)(hout + (size_t)m * D) + F.lane;
#pragma unroll
            for (int j = 0; j < 4; ++j) { v2u o; o.x = pk2(v[j].x, v[j].y); o.y = pk2(v[j].z, v[j].w); o8[64 * j] = o; }
        }
    }
}
__device__ __forceinline__ int t5_bucket(int d) {
    if (d < 16) return d;
    return 16 + (d >= 19) + (d >= 21) + (d >= 24) + (d >= 27) + (d >= 31) + (d >= 35) + (d >= 40) + (d >= 46) + (d >= 52) + (d >= 59) + (d >= 67) + (d >= 77) + (d >= 87) + (d >= 99) + (d >= 113);
}
__device__ __forceinline__ float softplus_f(float x) { return x > 20.f ? x : log1pf(__expf(x)); }

__device__ __forceinline__ void gdn_naive_item(Frame& F, const Args& A, bool prompt, int sidx, int h) {
    const bf16* cols = (const bf16*)(F.ws + WS_BIG); bf16* mix = (bf16*)(F.ws + WS_MIXIN);
    LAS float* ybuf = (LAS float*)(F.lds + RING_OFF);
    LAS float* red = ybuf + 384;
    LAS float* pa = ybuf + 512;
    LAS float* pb = pa + 512;
    LAS float* red2 = pb + 512;
    const int tid = F.tid, part = tid >> 7, dv = tid & 127, lane = F.lane, wave = F.wave;
    const int T = prompt ? SEQ : DECT, row0 = prompt ? sidx * SEQ : MP + sidx * DECT;
    float S[32];
    if (prompt) {
#pragma unroll
        for (int i = 0; i < 32; ++i) S[i] = 0.f;
    } else {
        const float* s0 = A.in[3] + ((size_t)(sidx * 4 + h) * 128 + part * 32) * 128 + dv;
#pragma unroll
        for (int i = 0; i < 32; ++i) S[i] = s0[(size_t)i * 128];
    }
    const int ch = tid, kind = ch >> 7, col = kind * 512 + h * 128 + (ch & 127);
    float w0 = 0.f, w1 = 0.f, w2 = 0.f, w3 = 0.f, r0 = 0.f, r1 = 0.f, r2 = 0.f;
    if (tid < 384) { const float* cw = A.in[17]; w0 = cw[col]; w1 = cw[1536 + col]; w2 = cw[2 * 1536 + col]; w3 = cw[3 * 1536 + col];
        if (!prompt) { const float* sc = A.in[2] + (size_t)sidx * 3 * 1536; r0 = sc[col]; r1 = sc[1536 + col]; r2 = sc[2 * 1536 + col]; } }
    const float Aneg = -__expf(A.in[18][h]), dtb = A.in[19][h], gain = A.in[20][dv];
    for (int t = 0; t < T; ++t) {
        const bf16* crow = cols + (size_t)(row0 + t) * LDC;
        if (tid < 384) {
            const float x = bf2f(crow[col]); float y = r0 * w0 + r1 * w1 + r2 * w2 + x * w3; r0 = r1; r1 = r2; r2 = x;
            y = silu_f(y); ybuf[ch] = y; const float sq = wave_sum(y * y); if (lane == 0) red[wave] = sq;
        }
        __syncthreads();
        const float rq = 0.08838834764831845f / sqrtf(red[0] + red[1] + 1e-6f), rk = 1.0f / sqrtf(red[2] + red[3] + 1e-6f);
        const float bb = bf2f(crow[C_B + h]), aa = bf2f(crow[C_A + h]);
        const float beta = sigm_f(bb), g = Aneg * softplus_f(aa + dtb), a = __expf(g);
        float ks = 0.f;
#pragma unroll
        for (int i = 0; i < 32; ++i) ks += ybuf[128 + part * 32 + i] * S[i];
        pa[part * 128 + dv] = ks;
        __syncthreads();
        const float kst = ((pa[dv] + pa[128 + dv]) + (pa[256 + dv] + pa[384 + dv])) * rk;
        const float vnew = beta * (ybuf[256 + dv] - a * kst);
        float op = 0.f;
#pragma unroll
        for (int i = 0; i < 32; ++i) { const float kk = ybuf[128 + part * 32 + i] * rk; S[i] = a * S[i] + kk * vnew; op += ybuf[part * 32 + i] * S[i]; }
        pb[part * 128 + dv] = op * rq;
        __syncthreads();
        const float o = (pb[dv] + pb[128 + dv]) + (pb[256 + dv] + pb[384 + dv]);
        if (tid < 128) { const float sq = wave_sum(o * o); if (lane == 0) red2[wave] = sq; }
        __syncthreads();
        if (tid < 128) { const float rn = 1.0f / sqrtf((red2[0] + red2[1]) * (1.f / 128.f) + EPS); const float zz = bf2f(crow[C_Z + h * 128 + dv]);
            mix[(size_t)(row0 + t) * D + h * 128 + dv] = (bf16)f2bf(o * rn * gain * silu_f(zz)); }
    }
    float* so = F.out + (prompt ? O_GDNP : O_GDNS) + ((size_t)(sidx * 4 + h) * 128 + part * 32) * 128 + dv;
#pragma unroll
    for (int i = 0; i < 32; ++i) so[(size_t)i * 128] = S[i];
    __syncthreads();
}

__device__ __forceinline__ void swa_scores(Frame& F, const Args& A, const bf16* cols, bool prompt, int b, int t, int s, int qi, int kh, int hf, LAS float* qs, float (&sc)[4]) {
    const int w = F.lane + 64 * hf, dist = 127 - w;
    bool valid = true; const bf16* kb = cols; const float* kf = nullptr;
    if (prompt) { const int pos = t - dist; valid = pos >= 0; kb = cols + (size_t)(b * SEQ + (valid ? pos : 0)) * LDC + C_KS + kh * 64; }
    else { const int j = qi + 1 + w; if (j < 128) kf = A.in[4] + ((size_t)(s * 128 + j) * 2 + kh) * 64; else kb = cols + (size_t)(MP + s * DECT + (j - 128)) * LDC + C_KS + kh * 64; }
    float a0 = 0.f, a1 = 0.f, a2 = 0.f, a3 = 0.f;
#pragma unroll 1
    for (int d4 = 0; d4 < 16; ++d4) {
        float k0, k1, k2, k3;
        if (kf) { const f32x4 x0 = ((const GAS f32x4*)kf)[d4]; k0 = x0.x; k1 = x0.y; k2 = x0.z; k3 = x0.w; }
        else { const v2u x = ((const GAS v2u*)kb)[d4]; k0 = bflo(x.x); k1 = bfhi(x.x); k2 = bflo(x.y); k3 = bfhi(x.y); }
        const LAS f32x4* q4 = (const LAS f32x4*)qs + d4;
        const f32x4 q0 = q4[0], q1 = q4[16], q2 = q4[32], q3 = q4[48];
        a0 += q0.x * k0 + q0.y * k1 + q0.z * k2 + q0.w * k3; a1 += q1.x * k0 + q1.y * k1 + q1.z * k2 + q1.w * k3;
        a2 += q2.x * k0 + q2.y * k1 + q2.z * k2 + q2.w * k3; a3 += q3.x * k0 + q3.y * k1 + q3.z * k2 + q3.w * k3;
    }
    const int bk = t5_bucket(dist); const float* rb = A.in[8] + bk * 8 + kh * 4;
    sc[0] = valid ? a0 + rb[0] : -INFINITY; sc[1] = valid ? a1 + rb[1] : -INFINITY; sc[2] = valid ? a2 + rb[2] : -INFINITY; sc[3] = valid ? a3 + rb[3] : -INFINITY;
}
__device__ __forceinline__ void swa_item(Frame& F, const Args& A, int m, int kh, LAS float* qs, LAS float* ps) {
    const bf16* cols = (const bf16*)(F.ws + WS_BIG); bf16* mix = (bf16*)(F.ws + WS_MIXIN);
    const int lane = F.lane; const bool prompt = m < MP;
    const int b = prompt ? m / SEQ : 0, t = prompt ? m % SEQ : 0, s = prompt ? 0 : (m - MP) / DECT, qi = prompt ? 0 : (m - MP) % DECT;
    const bf16* qrow = cols + (size_t)m * LDC + C_QS + kh * 256;
#pragma unroll
    for (int g = 0; g < 4; ++g) qs[g * 64 + lane] = bf2f(qrow[g * 64 + lane]) * 0.125f;
    LDS_WAIT(); asm volatile("" ::: "memory");
    float sc[2][4];
    swa_scores(F, A, cols, prompt, b, t, s, qi, kh, 0, qs, sc[0]);
    swa_scores(F, A, cols, prompt, b, t, s, qi, kh, 1, qs, sc[1]);
#pragma unroll
    for (int g = 0; g < 4; ++g) {
        const float sink = A.in[21][kh * 4 + g];
        const float mx = fmaxf(wave_max(fmaxf(sc[0][g], sc[1][g])), sink);
        const float e0 = __expf(sc[0][g] - mx), e1 = __expf(sc[1][g] - mx);
        const float den = wave_sum(e0 + e1) + __expf(sink - mx), inv = 1.0f / den;
        ps[g * 128 + lane] = e0 * inv; ps[g * 128 + 64 + lane] = e1 * inv;
    }
    LDS_WAIT(); asm volatile("" ::: "memory");
    float o0 = 0.f, o1 = 0.f, o2 = 0.f, o3 = 0.f;
    const int wlo = prompt ? (t >= 127 ? 0 : 127 - t) : 0;
#pragma unroll 2
    for (int w = wlo; w < 128; ++w) {
        float v;
        if (prompt) v = bf2f(cols[(size_t)(b * SEQ + t - 127 + w) * LDC + C_VS + kh * 64 + lane]);
        else { const int j = qi + 1 + w; v = j < 128 ? A.in[5][((size_t)(s * 128 + j) * 2 + kh) * 64 + lane] : bf2f(cols[(size_t)(MP + s * DECT + (j - 128)) * LDC + C_VS + kh * 64 + lane]); }
        o0 += ps[w] * v; o1 += ps[128 + w] * v; o2 += ps[256 + w] * v; o3 += ps[384 + w] * v;
    }
    bf16* orow = mix + (size_t)m * D + 512 + kh * 256;
    orow[lane] = (bf16)f2bf(o0); orow[64 + lane] = (bf16)f2bf(o1); orow[128 + lane] = (bf16)f2bf(o2); orow[192 + lane] = (bf16)f2bf(o3);
    LDS_WAIT(); asm volatile("" ::: "memory");
}

__device__ __forceinline__ void mixers_phase(Frame& F, const Args& A) {
    const bf16* cols = (const bf16*)(F.ws + WS_BIG);
#ifdef NO_GDN
    { bf16* mixz = (bf16*)(F.ws + WS_MIXIN); const int gt = blockIdx.x * (NWAVES * 64) + F.tid, NT = F.G * NWAVES * 64;
      for (size_t i = gt; i < (size_t)M * 512; i += NT) mixz[(i / 512) * D + (i % 512)] = 0;
      for (size_t i = gt; i < 2 * 4 * 128 * 128; i += NT) F.out[O_GDNP + i] = 0.f;
      for (size_t i = gt; i < (size_t)128 * 4 * 128 * 128; i += NT) F.out[O_GDNS + i] = 0.f; }
#else
    for (int it = blockIdx.x; it < 8 + DECB * 4; it += F.G) {
        if (it < 8) gdn_naive_item(F, A, true, it >> 2, it & 3); else gdn_naive_item(F, A, false, (it - 8) >> 2, (it - 8) & 3);
    }
#endif
#ifdef NO_SWA
    { bf16* mixz = (bf16*)(F.ws + WS_MIXIN); const int gt = blockIdx.x * (NWAVES * 64) + F.tid, NT = F.G * NWAVES * 64;
      for (size_t i = gt; i < (size_t)M * 512; i += NT) mixz[(i / 512) * D + 512 + (i % 512)] = 0; }
#else
    { LAS float* qs = (LAS float*)(F.lds + RING_OFF + F.wave * 16384); LAS float* ps = qs + 256;
      const int gw = F.vcu * NWAVES + F.wave, NGW = F.G * NWAVES;
      for (int it = gw; it < M * 2; it += NGW) swa_item(F, A, it >> 1, it & 1, qs, ps); }
#endif
    { const int gt = blockIdx.x * (NWAVES * 64) + F.tid, NT = F.G * NWAVES * 64;
      for (int i = gt; i < 2 * 3 * 1536; i += NT) { const int c = i % 1536, r = (i / 1536) % 3, b = i / (3 * 1536); F.out[O_CONVP + i] = bf2f(cols[(size_t)(b * SEQ + SEQ - 3 + r) * LDC + c]); }
      for (int i = gt; i < 2 * 128 * 128; i += NT) { const int c = i % 128, r = (i / 128) % 128, b = i / (128 * 128); const size_t ro = (size_t)(b * SEQ + SEQ - 128 + r) * LDC;
          F.out[O_KP + i] = bf2f(cols[ro + C_KS + c]); F.out[O_VP + i] = bf2f(cols[ro + C_VS + c]); }
      for (int i = gt; i < DECB * 3 * 1536; i += NT) { const int c = i % 1536, r = (i / 1536) % 3, s = i / (3 * 1536); F.out[O_CONVS + i] = bf2f(cols[(size_t)(MP + s * DECT + 1 + r) * LDC + c]); }
      for (int i = gt; i < DECB * 128 * 128; i += NT) { const int c = i % 128, j = (i / 128) % 128, s = i / (128 * 128);
          if (j < 124) { F.out[O_KS + i] = A.in[4][(size_t)(s * 128 + j + 4) * 128 + c]; F.out[O_VS + i] = A.in[5][(size_t)(s * 128 + j + 4) * 128 + c]; }
          else { const size_t ro = (size_t)(MP + s * DECT + (j - 124)) * LDC; F.out[O_KS + i] = bf2f(cols[ro + C_KS + c]); F.out[O_VS + i] = bf2f(cols[ro + C_VS + c]); } }
    }
}
__global__ void __launch_bounds__(NWAVES * 64, 2) mk_fwd(Args args) {
    extern __shared__ __attribute__((aligned(16))) unsigned char lds[];
    Frame F;
    F.lds = (LAS unsigned char*)lds;
    F.MISC = (volatile LAS unsigned*)(F.lds + MISC_OFF);
    F.tid = threadIdx.x; F.lane = F.tid & 63; F.wave = __builtin_amdgcn_readfirstlane(F.tid >> 6);
    F.G = gridDim.x; { const int bx = blockIdx.x; F.vcu = (F.G % 8 == 0) ? (bx % 8) * (F.G / 8) + bx / 8 : bx; }
    F.ws = args.ws; F.out = args.out; F.ctl = (gu32*)(args.ws + WS_CTL);
    for (int u = F.tid; u < (LDS_BYTES - LDSCTL_OFF) / 4; u += NWAVES * 64) ((LAS unsigned*)(F.lds + LDSCTL_OFF))[u] = 0u;
    __syncthreads();
    const int lo = args.ph_lo, hi = args.ph_hi;
    XcdBarrier bar; bar.bar = (unsigned*)(F.ctl + CW_BAR); bar.x = 0; bar.st = nullptr;
    if (hi - lo > 1 || DBG_STOP < 99) bar = xcd_barrier_post((unsigned*)(F.ctl + CW_BAR), F.MISC + 8);
#ifndef PH_MASK
#define PH_MASK 0xffffffffu
#endif
#define IN(k) (((PH_MASK >> (k)) & 1u) && lo <= (k) && (k) < hi && (k) <= DBG_STOP)
#define SEAM(k) do { if (IN(k) && IN((k) + 1)) xcd_barrier(bar); } while (0)
    bf16* HB = (bf16*)(F.ws + WS_HBUF); bf16* BIG = (bf16*)(F.ws + WS_BIG); bf16* TMP = (bf16*)(F.ws + WS_TMP); bf16* MIX = (bf16*)(F.ws + WS_MIXIN); bf16* PB = (bf16*)(F.ws + WS_PBUF);
    const int bx = (int)blockIdx.x;

    if (IN(0)) { p0_prologue(F, args); } SEAM(0);
    if (IN(1)) { pg8::Gemm g{HB, (const bf16*)(F.ws + WS_WGU1), M, 2 * FF, D}; pg8::StaticOrder S; S.init(M, 2 * FF, F.G, bx); pg8::EpiGen<1> E{BIG, FF, nullptr};
        pg8::gemm_phase<pg8::EpiGen<1>, pg8::StaticOrder, true, true>(F.lds + RING_OFF, g, S, E); } SEAM(1);
    if (IN(2)) { pg8::Gemm g{BIG, (const bf16*)(F.ws + WS_WD1), M, D, FF}; pg8::StaticOrder S; S.init(M, D, F.G, bx); pg8::EpiGen<0> E{TMP, D, nullptr};
        pg8::gemm_phase<pg8::EpiGen<0>, pg8::StaticOrder, true, true>(F.lds + RING_OFF, g, S, E); } SEAM(2);
    if (IN(3)) { resid_pass<1, true>(F, args.in[0], args.in[1], TMP, 0.5f, args.in[10], args.in[14], HB); } SEAM(3);
    if (IN(4)) { pg8::Gemm g{HB, (const bf16*)(F.ws + WS_WIN), M, LDC, D}; pg8::StaticOrder S; S.init(M, LDC, F.G, bx); pg8::EpiGen<0> E{BIG, LDC, nullptr};
        pg8::gemm_phase<pg8::EpiGen<0>, pg8::StaticOrder, true, true>(F.lds + RING_OFF, g, S, E); } SEAM(4);
    if (IN(5)) { mixers_phase(F, args); } SEAM(5);
    if (IN(6)) { pg8::Gemm g{MIX, (const bf16*)(F.ws + WS_WOUT), M, D, D}; pg8::StaticOrder S; S.init(M, D, F.G, bx); pg8::EpiGen<0> E{TMP, D, nullptr};
        pg8::gemm_phase<pg8::EpiGen<0>, pg8::StaticOrder, true, true>(F.lds + RING_OFF, g, S, E); } SEAM(6);
    if (IN(7)) { resid_pass<1, false>(F, nullptr, nullptr, TMP, 1.0f, args.in[15], args.in[23], HB); } SEAM(7);
    if (IN(8)) { pg8::Gemm g{HB, (const bf16*)(F.ws + WS_WGU2), M, 2 * FF, D}; pg8::StaticOrder S; S.init(M, 2 * FF, F.G, bx); pg8::EpiGen<1> E{BIG, FF, nullptr};
        pg8::gemm_phase<pg8::EpiGen<1>, pg8::StaticOrder, true, true>(F.lds + RING_OFF, g, S, E); } SEAM(8);
    if (IN(9)) { pg8::Gemm g{BIG, (const bf16*)(F.ws + WS_WD2), M, D, FF}; pg8::StaticOrder S; S.init(M, D, F.G, bx); pg8::EpiGen<0> E{TMP, D, nullptr};
        pg8::gemm_phase<pg8::EpiGen<0>, pg8::StaticOrder, true, true>(F.lds + RING_OFF, g, S, E); } SEAM(9);
    if (IN(10)) { resid_pass<2, false>(F, nullptr, nullptr, TMP, 0.5f, args.in[24], nullptr, HB); } SEAM(10);
    if (IN(11)) { pg8::Gemm g{HB, (const bf16*)(F.ws + WS_WPG), M, D, D}; pg8::StaticOrder S; S.init(M, D, F.G, bx); pg8::EpiGen<2> E{TMP, D, nullptr};
        pg8::gemm_phase<pg8::EpiGen<2>, pg8::StaticOrder, true, true>(F.lds + RING_OFF, g, S, E); } SEAM(11);
    if (IN(12)) { pg8::Gemm g{PB, (const bf16*)(F.ws + WS_WPP), M, D, PLE}; pg8::StaticOrder S; S.init(M, D, F.G, bx); pg8::EpiGen<3> E{MIX, D, TMP};
        pg8::gemm_phase<pg8::EpiGen<3>, pg8::StaticOrder, true, true>(F.lds + RING_OFF, g, S, E); } SEAM(12);
    if (IN(13)) { resid_pass<0, false>(F, nullptr, nullptr, MIX, 1.0f, args.in[30], nullptr, nullptr); }

#if DBG_STOP < 99
    xcd_barrier(bar);
    { const bf16* dsrc = (const bf16*)(F.ws + DBG_BUF); const size_t gt = (size_t)blockIdx.x * (NWAVES * 64) + F.tid, NT = (size_t)F.G * NWAVES * 64;
      if (DBG_LD > 0) for (size_t i = gt; i < (size_t)M * D; i += NT) F.out[i] = bf2f(dsrc[(i / D) * DBG_LD + (i % D)]);
      for (size_t i = (size_t)M * D + gt; i < O_END; i += NT) F.out[i] = 0.f; }
#endif
#undef IN
#undef SEAM
}

extern "C" void kernel_launch(void* const* d_in, const int* in_sizes, int n_in, void* d_out, int out_size, void* d_ws, size_t ws_size, hipStream_t stream) {
    static int grid = 0;
    if (grid == 0) {
        if (n_in != 31 || (size_t)out_size != O_END || ws_size < WS_END) { fprintf(stderr, "kernel_launch: unexpected shapes: n_in %d out %d ws %zu\n", n_in, out_size, ws_size); grid = -1; return; }
        int dev = 0, cus = 0, per_cu = 0;
        if (hipGetDevice(&dev) != hipSuccess || hipDeviceGetAttribute(&cus, hipDeviceAttributeMultiprocessorCount, dev) != hipSuccess) { grid = -1; return; }
        if (hipFuncSetAttribute((const void*)mk_fwd, hipFuncAttributeMaxDynamicSharedMemorySize, LDS_BYTES) != hipSuccess) { fprintf(stderr, "kernel_launch: hipFuncSetAttribute failed\n"); grid = -1; return; }
        if (hipOccupancyMaxActiveBlocksPerMultiprocessor(&per_cu, (const void*)mk_fwd, NWAVES * 64, LDS_BYTES) != hipSuccess || per_cu < 1) { fprintf(stderr, "kernel_launch: occupancy query says %d\n", per_cu); }
        (void)hipGetLastError();
        grid = cus;
    }
    if (grid < 0) return;
    (void)hipMemsetAsync((char*)d_ws + WS_CTL, 0, CTL_ZERO_BYTES, stream);
    Args a{};
    for (int i = 0; i < 31; ++i) a.in[i] = (const float*)d_in[i];
    a.out = (float*)d_out; a.ws = (unsigned char*)d_ws;
    constexpr int NL = MK_N_LAUNCHES;
    for (int li = 0; li < NL; ++li) {
        a.ph_lo = (NL == 1) ? 0 : li; a.ph_hi = (NL == 1) ? N_PHASES : li + 1;
        hipLaunchKernelGGL(mk_fwd, dim3(grid), dim3(NWAVES * 64), LDS_BYTES, stream, a);
    }
}
```

```cpp
#include <hip/hip_runtime.h>
#ifndef DBG_STOP
#define DBG_STOP 99
#endif
#include <cstdio>
#include <cstdint>
namespace pg8 {
#define PG8_LAS __attribute__((address_space(3)))
typedef unsigned short bf16_t;
typedef short bf16x8 __attribute__((ext_vector_type(8)));
typedef float f32x4 __attribute__((ext_vector_type(4)));
typedef unsigned u32x4 __attribute__((ext_vector_type(4)));
constexpr int BM = 256, BK = 64, HALF = 128, HTB = HALF * BK * 2  , STAGE_BYTES = 8 * HTB, NXCD = 8, WGM = 8;

__host__ __device__ __forceinline__ int lds_byte(int r, int c) { const int st = (r >> 4) * 2 + (c >> 5), rr = r & 15, cc = c & 31, ob = rr * 64 + cc * 2; return st * 1024 + (ob ^ (((ob >> 9) & 1) << 5)); }
__host__ __device__ __forceinline__ void stage_rc(int b, int& R, int& C) { const int st = b / 1024, sb = b % 1024, swz = sb ^ (((sb >> 9) & 1) << 5); R = (st >> 1) * 16 + swz / 64; C = (st & 1) * 32 + (swz % 64) / 2; }
__host__ __device__ __forceinline__ int perm32(int rho) { const int n = rho >> 4, i = rho & 15; return 8 * (i >> 2) + 4 * n + (i & 3); }

struct Unit { int pm, pn; };
struct Gemm { const bf16_t* A; const bf16_t* Bt; int M, N, K; };

struct StaticOrder {
    int nM, nN, nwg, G, c;
    __host__ __device__ void init(int M, int N, int G_, int c_) { nM = M / BM; nN = N / BM; nwg = nM * nN; G = G_; c = c_; }
    __host__ __device__ bool next(int i, Unit& u) const {
        const long L = (long)i * G + c; if (L >= nwg) return false;
        int wgid = (int)L; { const int q = nwg / NXCD, r = nwg % NXCD, xcd = wgid % NXCD, off = wgid / NXCD; wgid = (xcd < r ? xcd * (q + 1) : r * (q + 1) + (xcd - r) * q) + off; }
        const int nig = WGM * nN, gid = wgid / nig, fm = gid * WGM, gsz = (nM - fm) < WGM ? (nM - fm) : WGM;
        u.pm = fm + ((wgid % nig) % gsz); u.pn = (wgid % nig) / gsz; return true;
    }
    __device__ __forceinline__ void a_ready(const Unit&) const {}
    __device__ __forceinline__ void done(const Unit&) const {}
};

typedef float f32x2_t __attribute__((ext_vector_type(2))); typedef __bf16 bf16x2_t __attribute__((ext_vector_type(2)));
__device__ __forceinline__ unsigned cvt_pk_bf16(float lo, float hi) { f32x2_t v = {lo, hi}; bf16x2_t b = __builtin_convertvector(v, bf16x2_t); return __builtin_bit_cast(unsigned, b); }
template <int MODE> struct EpiGen {
    static constexpr bool PERM = true, AFTER_DRAIN = false;
    bf16_t* O; int ldc; const bf16_t* aux;
    __device__ __forceinline__ static float silu_f(float g) { return g * __builtin_amdgcn_rcpf(1.0f + __expf(-g)); }
    __device__ __forceinline__ static float sigm_f(float g) { return __builtin_amdgcn_rcpf(1.0f + __expf(-g)); }
    __device__ __forceinline__ void operator()(const f32x4 (&acc)[2][2][4][2], const Unit& u, int wr, int wc, int fr, int fq) const {
        const int row0 = u.pm * BM + wr * 64 + fr;
        if constexpr (MODE == 1) {
            const int col0 = u.pn * HALF + wc * 32 + 8 * fq;
#pragma unroll
            for (int ai = 0; ai < 2; ++ai)
#pragma unroll
                for (int m = 0; m < 4; ++m) { bf16_t* rowp = O + (size_t)(row0 + ai * HALF + m * 16) * ldc + col0;
                    const f32x4 g0 = acc[ai][0][m][0], g1 = acc[ai][0][m][1], u0 = acc[ai][1][m][0], u1 = acc[ai][1][m][1];
                    u32x4 w; w.x = cvt_pk_bf16(silu_f(g0[0]) * u0[0], silu_f(g0[1]) * u0[1]); w.y = cvt_pk_bf16(silu_f(g0[2]) * u0[2], silu_f(g0[3]) * u0[3]);
                    w.z = cvt_pk_bf16(silu_f(g1[0]) * u1[0], silu_f(g1[1]) * u1[1]); w.w = cvt_pk_bf16(silu_f(g1[2]) * u1[2], silu_f(g1[3]) * u1[3]);
                    *(u32x4*)rowp = w; }
        } else {
            const int col0 = u.pn * BM + wc * 32 + 8 * fq;
#pragma unroll
            for (int ai = 0; ai < 2; ++ai)
#pragma unroll
                for (int m = 0; m < 4; ++m) { const size_t off = (size_t)(row0 + ai * HALF + m * 16) * ldc + col0;
#pragma unroll
                    for (int bj = 0; bj < 2; ++bj) { f32x4 v0 = acc[ai][bj][m][0], v1 = acc[ai][bj][m][1];
                        if constexpr (MODE == 2) { v0 = (f32x4){sigm_f(v0[0]), sigm_f(v0[1]), sigm_f(v0[2]), sigm_f(v0[3])}; v1 = (f32x4){sigm_f(v1[0]), sigm_f(v1[1]), sigm_f(v1[2]), sigm_f(v1[3])}; }
                        if constexpr (MODE == 3) { const u32x4 a = *(const u32x4*)(aux + off + bj * HALF);
                            v0[0] *= __uint_as_float(a.x << 16); v0[1] *= __uint_as_float(a.x & 0xffff0000u); v0[2] *= __uint_as_float(a.y << 16); v0[3] *= __uint_as_float(a.y & 0xffff0000u);
                            v1[0] *= __uint_as_float(a.z << 16); v1[1] *= __uint_as_float(a.z & 0xffff0000u); v1[2] *= __uint_as_float(a.w << 16); v1[3] *= __uint_as_float(a.w & 0xffff0000u); }
                        u32x4 w; w.x = cvt_pk_bf16(v0[0], v0[1]); w.y = cvt_pk_bf16(v0[2], v0[3]); w.z = cvt_pk_bf16(v1[0], v1[1]); w.w = cvt_pk_bf16(v1[2], v1[3]);
                        *(u32x4*)(O + off + bj * HALF) = w; } }
        }
    }
};
template <class Epi, class Sched, bool ALIGN_EPI = false, bool SP2 = false>
__device__ __forceinline__ void gemm_phase(PG8_LAS unsigned char* lds, const Gemm g, const Sched& S, const Epi& E) {
    const int tid = threadIdx.x, wid = __builtin_amdgcn_readfirstlane(tid >> 6), lane = tid & 63, wr = wid >> 2, wc = wid & 3, fr = lane & 15, fq = lane >> 4;
    const int K = g.K, nt = K / BK;
    unsigned voffA[2], voffB[2];
#pragma unroll
    for (int i = 0; i < 2; ++i) { int R, C; stage_rc(tid * 16 + i * 8192, R, C); const int Rb = Epi::PERM ? ((R & ~31) + perm32(R & 31)) : R;
        voffA[i] = (unsigned)(R * K + C) * 2u; voffB[i] = (unsigned)(Rb * K + C) * 2u; }
    const size_t kstep = (size_t)(BK * 2);
    const size_t hstep = (size_t)HALF * K * 2;
    const size_t tstep = 2 * hstep;
    const unsigned ldsw = (unsigned)wid * 1024u;
    const int aoff = lds_byte(wr * 64 + fr, fq * 8), boff = lds_byte(wc * 32 + fr, fq * 8);
#define PG8_SA(b, h) (((b) * 2 + (h)) * HTB)
#define PG8_SB(b, h) ((4 + (b) * 2 + (h)) * HTB)
#define PG8_STAGE(bufoff, gbase, voff) do { _Pragma("unroll") for (int _i = 0; _i < 2; ++_i) \
        __builtin_amdgcn_global_load_lds((const unsigned*)((const char*)(gbase) + (voff)[_i]), (PG8_LAS unsigned*)(lds + (bufoff) + ldsw + _i * 8192), 16, 0, 0); } while (0)
#define PG8_LDA(dst, b, h) do { _Pragma("unroll") for (int m = 0; m < 4; ++m) _Pragma("unroll") for (int k = 0; k < 2; ++k) dst[m][k] = *(const PG8_LAS bf16x8*)(lds + PG8_SA(b, h) + aoff + m * 2048 + k * 1024); } while (0)
#define PG8_LDB(dst, b, h) do { _Pragma("unroll") for (int n = 0; n < 2; ++n) _Pragma("unroll") for (int k = 0; k < 2; ++k) dst[n][k] = *(const PG8_LAS bf16x8*)(lds + PG8_SB(b, h) + boff + n * 2048 + k * 1024); } while (0)
#define PG8_MMA(ai, bj, At, Bt) do { __builtin_amdgcn_s_setprio(1); _Pragma("unroll") for (int m = 0; m < 4; ++m) _Pragma("unroll") for (int n = 0; n < 2; ++n) _Pragma("unroll") for (int k = 0; k < 2; ++k) \
        acc[ai][bj][m][n] = __builtin_amdgcn_mfma_f32_16x16x32_bf16(Bt[n][k], At[m][k], acc[ai][bj][m][n], 0, 0, 0); __builtin_amdgcn_s_setprio(0); } while (0)
#define PG8_WAIT_V(n) asm volatile("s_waitcnt vmcnt(" #n ")" ::: "memory")
#define PG8_WAIT_L(n) asm volatile("s_waitcnt lgkmcnt(" #n ")" ::: "memory")
#define PG8_BAR __builtin_amdgcn_s_barrier()
#define PG8_SCHED __builtin_amdgcn_sched_barrier(0)
    Unit cur, nxt; int ui = 0;
    if (!S.next(0, cur)) return;
    f32x4 acc[2][2][4][2];
#pragma unroll
    for (int a = 0; a < 2; ++a)
#pragma unroll
        for (int b = 0; b < 2; ++b)
#pragma unroll
            for (int m = 0; m < 4; ++m)
#pragma unroll
                for (int n = 0; n < 2; ++n) acc[a][b][m][n] = (f32x4){0.f, 0.f, 0.f, 0.f};
    bf16x8 At[4][2], B0[2][2], B1[2][2];
    const char* cA = (const char*)g.A + (size_t)cur.pm * tstep; const char* cB = (const char*)g.Bt + (size_t)cur.pn * tstep;
    S.a_ready(cur);
    if constexpr (SP2) {
        PG8_STAGE(PG8_SB(0, 0), cB, voffB); PG8_STAGE(PG8_SB(0, 1), cB + hstep, voffB); PG8_STAGE(PG8_SA(0, 0), cA, voffA); PG8_STAGE(PG8_SA(0, 1), cA + hstep, voffA);
        if (wr == 1) PG8_BAR;
        PG8_WAIT_V(2); PG8_BAR;
        PG8_STAGE(PG8_SB(1, 0), cB + kstep, voffB); PG8_STAGE(PG8_SA(1, 0), cA + kstep, voffA); PG8_STAGE(PG8_SB(1, 1), cB + hstep + kstep, voffB);
        PG8_WAIT_V(6); PG8_BAR;
    } else {
        PG8_STAGE(PG8_SB(0, 0), cB, voffB); PG8_STAGE(PG8_SA(0, 0), cA, voffA); PG8_STAGE(PG8_SB(0, 1), cB + hstep, voffB); PG8_STAGE(PG8_SA(0, 1), cA + hstep, voffA);
        if (wr == 1) PG8_BAR;
        PG8_WAIT_V(4); PG8_BAR;
        PG8_STAGE(PG8_SB(1, 0), cB + kstep, voffB); PG8_STAGE(PG8_SA(1, 0), cA + kstep, voffA); PG8_STAGE(PG8_SB(1, 1), cB + hstep + kstep, voffB);
        PG8_WAIT_V(6); PG8_BAR;
    }
    for (;;) {
        const bool has_next = S.next(ui + 1, nxt);
        const char* nA = has_next ? (const char*)g.A + (size_t)nxt.pm * tstep : cA; const char* nB = has_next ? (const char*)g.Bt + (size_t)nxt.pn * tstep : cB;
        for (int t = 0; t < nt; t += 2) {
            const bool last = (t == nt - 2);
            const char* a1 = cA + (size_t)(t + 1) * kstep;
            const char* a2 = last ? nA : cA + (size_t)(t + 2) * kstep; const char* b2 = last ? nB : cB + (size_t)(t + 2) * kstep;
            const char* a3 = a2 + kstep; const char* b3 = b2 + kstep;
            if (last && has_next) S.a_ready(nxt);
            if constexpr (SP2) {
            PG8_LDB(B0, 0, 0); PG8_LDB(B1, 0, 1); PG8_SCHED; PG8_LDA(At, 0, 0); PG8_STAGE(PG8_SA(1, 1), a1 + hstep, voffA);
            PG8_WAIT_V(8); PG8_WAIT_L(0); PG8_BAR; PG8_MMA(0, 0, At, B0); PG8_MMA(0, 1, At, B1); PG8_BAR; PG8_SCHED;
            PG8_LDA(At, 0, 1); PG8_STAGE(PG8_SB(0, 0), b2, voffB); PG8_STAGE(PG8_SB(0, 1), b2 + hstep, voffB); PG8_STAGE(PG8_SA(0, 0), a2, voffA);
            PG8_WAIT_V(8); PG8_WAIT_L(0); PG8_BAR; PG8_MMA(1, 0, At, B0); PG8_MMA(1, 1, At, B1); PG8_BAR; PG8_SCHED;
            PG8_LDB(B0, 1, 0); PG8_LDB(B1, 1, 1); PG8_SCHED; PG8_LDA(At, 1, 0); PG8_STAGE(PG8_SA(0, 1), a2 + hstep, voffA);
            PG8_WAIT_V(8); PG8_WAIT_L(0); PG8_BAR; PG8_MMA(0, 0, At, B0); PG8_MMA(0, 1, At, B1); PG8_BAR; PG8_SCHED;
            PG8_LDA(At, 1, 1); PG8_STAGE(PG8_SB(1, 0), b3, voffB); PG8_STAGE(PG8_SB(1, 1), b3 + hstep, voffB); PG8_STAGE(PG8_SA(1, 0), a3, voffA);
            PG8_WAIT_V(8); PG8_WAIT_L(0); PG8_BAR; PG8_MMA(1, 0, At, B0); PG8_MMA(1, 1, At, B1); PG8_BAR; PG8_SCHED;
            } else {
            PG8_LDB(B0, 0, 0); PG8_SCHED; PG8_LDA(At, 0, 0); PG8_STAGE(PG8_SA(1, 1), a1 + hstep, voffA);
            PG8_WAIT_L(8); PG8_BAR; PG8_WAIT_L(0); PG8_MMA(0, 0, At, B0); PG8_BAR; PG8_SCHED;
            PG8_LDB(B1, 0, 1); PG8_STAGE(PG8_SB(0, 0), b2, voffB);
            PG8_BAR; PG8_WAIT_L(0); PG8_MMA(0, 1, At, B1); PG8_BAR;
            PG8_LDA(At, 0, 1); PG8_STAGE(PG8_SA(0, 0), a2, voffA);
            PG8_BAR; PG8_WAIT_L(0); PG8_MMA(1, 0, At, B0); PG8_BAR; PG8_SCHED;
            PG8_STAGE(PG8_SB(0, 1), b2 + hstep, voffB);
            PG8_WAIT_V(6); PG8_BAR; PG8_MMA(1, 1, At, B1); PG8_BAR;
            PG8_LDB(B0, 1, 0); PG8_SCHED; PG8_LDA(At, 1, 0); PG8_STAGE(PG8_SA(0, 1), a2 + hstep, voffA);
            PG8_WAIT_L(8); PG8_BAR; PG8_WAIT_L(0); PG8_MMA(0, 0, At, B0); PG8_BAR; PG8_SCHED;
            PG8_LDB(B1, 1, 1); PG8_STAGE(PG8_SB(1, 0), b3, voffB);
            PG8_BAR; PG8_WAIT_L(0); PG8_MMA(0, 1, At, B1); PG8_BAR;
            PG8_LDA(At, 1, 1); PG8_STAGE(PG8_SA(1, 0), a3, voffA);
            PG8_BAR; PG8_WAIT_L(0); PG8_MMA(1, 0, At, B0); PG8_BAR; PG8_SCHED;
            PG8_STAGE(PG8_SB(1, 1), b3 + hstep, voffB);
            PG8_WAIT_V(6); PG8_BAR; PG8_MMA(1, 1, At, B1); PG8_BAR;
            }
        }
        if constexpr (ALIGN_EPI) { if (wr == 0) PG8_BAR; }
        if constexpr (!Epi::AFTER_DRAIN) { E(acc, cur, wr, wc, fr, fq); S.done(cur); }
        if (!has_next) break;
#pragma unroll
        for (int a = 0; a < 2; ++a)
#pragma unroll
            for (int b = 0; b < 2; ++b)
#pragma unroll
                for (int m = 0; m < 4; ++m)
#pragma unroll
                    for (int n = 0; n < 2; ++n) acc[a][b][m][n] = (f32x4){0.f, 0.f, 0.f, 0.f};
        cur = nxt; cA = nA; cB = nB; ++ui;
        if constexpr (ALIGN_EPI) { if (wr == 1) PG8_BAR; }
    }
    PG8_WAIT_V(0);
    if constexpr (!ALIGN_EPI) { if (wr == 0) PG8_BAR; }
    PG8_BAR;
    if constexpr (Epi::AFTER_DRAIN) { E.fused(acc, cur, wr, wc, fr, fq, lds, wid, lane); S.done(cur); }
#undef PG8_SA
#undef PG8_SB
#undef PG8_STAGE
#undef PG8_LDA
#undef PG8_LDB
#undef PG8_MMA
#undef PG8_WAIT_V
#undef PG8_WAIT_L
#undef PG8_BAR
#undef PG8_SCHED
}
}

#ifndef PG8_SP2
#define PG8_SP2 true
#endif
#ifndef PG8_ALIGN
#define PG8_ALIGN true
#endif
constexpr int NWAVES = 8;
#ifndef MK_N_LAUNCHES
#define MK_N_LAUNCHES 1
#endif
constexpr int N_PHASES = 16;
constexpr int D = 1024, SEQ = 8192, NB = 2, MP = NB * SEQ, DECB = 128, DECT = 4, MS = DECB * DECT, M = MP + MS;
constexpr int FF = 2816, PLE = 256, NIN = 2824, LDC = 3072;
constexpr int C_Q = 0, C_K = 512, C_V = 1024, C_Z = 1536, C_QS = 2048, C_KS = 2560, C_VS = 2688, C_B = 2816, C_A = 2820;
constexpr float EPS = 1e-6f;
constexpr size_t O_Y = 0, O_CONVP = (size_t)M * D, O_GDNP = O_CONVP + 2 * 3 * 1536, O_KP = O_GDNP + 2 * 4 * 128 * 128, O_VP = O_KP + 2 * 128 * 2 * 64,
                 O_CONVS = O_VP + 2 * 128 * 2 * 64, O_GDNS = O_CONVS + (size_t)128 * 3 * 1536, O_KS = O_GDNS + (size_t)128 * 4 * 128 * 128, O_VS = O_KS + (size_t)128 * 128 * 2 * 64,
                 O_END = O_VS + (size_t)128 * 128 * 2 * 64;
constexpr size_t MiB = 1u << 20, KiB = 1024;
constexpr size_t WS_CTL = 0, CTL_ZERO_BYTES = 1 * MiB;
constexpr size_t WS_WGU1 = 1 * MiB, WS_WD1 = 12 * MiB, WS_WIN = 17 * MiB + 512 * KiB, WS_WOUT = 23 * MiB + 512 * KiB, WS_WGU2 = 25 * MiB + 512 * KiB, WS_WD2 = 36 * MiB + 512 * KiB,
                 WS_WPG = 42 * MiB, WS_WPP = 44 * MiB, WS_PBUF = 45 * MiB, WS_HBUF = 54 * MiB, WS_BIG = 87 * MiB, WS_TMP = 186 * MiB, WS_MIXIN = 219 * MiB, WS_END = 252 * MiB;
static_assert(WS_WGU1 + (size_t)2 * FF * D * 2 <= WS_WD1 && WS_WD1 + (size_t)D * FF * 2 <= WS_WIN && WS_WIN + (size_t)LDC * D * 2 <= WS_WOUT && WS_WOUT + (size_t)D * D * 2 <= WS_WGU2 &&
              WS_WGU2 + (size_t)2 * FF * D * 2 <= WS_WD2 && WS_WD2 + (size_t)D * FF * 2 <= WS_WPG && WS_WPG + (size_t)D * D * 2 <= WS_WPP && WS_WPP + (size_t)D * PLE * 2 <= WS_PBUF &&
              WS_PBUF + (size_t)M * PLE * 2 <= WS_HBUF && WS_HBUF + (size_t)M * D * 2 <= WS_BIG && WS_BIG + (size_t)M * LDC * 2 <= WS_TMP && WS_TMP + (size_t)M * D * 2 <= WS_MIXIN &&
              WS_MIXIN + (size_t)M * D * 2 <= WS_END, "d_ws map");
constexpr int CW_TMO = 0, CW_CODE = 1, CW_BAR = 4096;
constexpr int RING_OFF = 0, RING_BYTES = 131072, LDSCTL_OFF = RING_BYTES, MISC_OFF = LDSCTL_OFF + 320, LDS_BYTES = 147456;

#define GAS __attribute__((address_space(1)))
#define LAS __attribute__((address_space(3)))
typedef unsigned short bf16;
typedef unsigned v4u __attribute__((ext_vector_type(4)));
typedef unsigned v2u __attribute__((ext_vector_type(2)));
typedef float f32x4 __attribute__((ext_vector_type(4)));
typedef GAS unsigned gu32;
#define RLX_AGENT __ATOMIC_RELAXED, __HIP_MEMORY_SCOPE_AGENT
#define LDS_WAIT() asm volatile("s_waitcnt lgkmcnt(0)" ::: "memory")
#define VM_WAIT() asm volatile("s_waitcnt vmcnt(0)" ::: "memory")
__device__ __forceinline__ unsigned f2bf(float f) { unsigned u = __builtin_bit_cast(unsigned, f); return (u + 0x7fffu + ((u >> 16) & 1u)) >> 16; }
__device__ __forceinline__ unsigned pk2(float lo, float hi) { return f2bf(lo) | (f2bf(hi) << 16); }
__device__ __forceinline__ float bf2f(bf16 u) { return __uint_as_float((unsigned)u << 16); }
__device__ __forceinline__ float bflo(unsigned u) { return __uint_as_float(u << 16); }
__device__ __forceinline__ float bfhi(unsigned u) { return __uint_as_float(u & 0xffff0000u); }
#define XB_TMO      128
#define XB_XCNT(j)  (256  + 64 * (j))
#define XB_XSUB(j)  (1280 + 64 * (j))
#define XB_XGEN(j)  (2304 + 64 * (j))
#define XB_TOP      3328
#define XB_TOPGEN   3392
#define XCD_BAR_WORDS 3456
#define XB_SPIN_CAP (1u << 27)

__device__ __forceinline__ unsigned xb_ld(unsigned* p)              { return __hip_atomic_load(p, __ATOMIC_RELAXED, __HIP_MEMORY_SCOPE_AGENT); }
__device__ __forceinline__ unsigned xb_add(unsigned* p, unsigned v) { return __hip_atomic_fetch_add(p, v, __ATOMIC_RELAXED, __HIP_MEMORY_SCOPE_AGENT); }
__device__ __forceinline__ unsigned xb_xcc_id() { return (unsigned)__builtin_amdgcn_s_getreg((3 << 11) | 20) & 0xFu; }
#define XB_SPIN(cond, bar) do { unsigned _sp = 0; while (cond) { __builtin_amdgcn_s_sleep(1); \
    if ((++_sp & 255u) == 0u) { if (xb_ld(&(bar)[XB_TMO])) break; if (_sp > XB_SPIN_CAP) { atomicAdd(&(bar)[XB_TMO], 1u); break; } } } } while (0)

struct XcdBarrier {
    unsigned* bar; unsigned x;
    volatile LAS unsigned* st;
};

__device__ __forceinline__ XcdBarrier xcd_barrier_post(unsigned* bar, volatile LAS unsigned* st) {
    XcdBarrier b; b.bar = bar; b.x = xb_xcc_id(); b.st = st;
    if (threadIdx.x == 0) (void)xb_add(&bar[XB_XCNT(b.x)], 1u);
    return b;
}
__device__ __forceinline__ void xcd_barrier_complete(unsigned* bar, unsigned x, unsigned& nloc, unsigned& nx) {
    const unsigned G = gridDim.x * gridDim.y * gridDim.z;
    unsigned sum, cnt, mine, sp = 0u;
    for (;;) {
        sum = 0u; cnt = 0u; mine = 0u;
#pragma unroll
        for (unsigned j = 0; j < 16; ++j) { const unsigned c = xb_ld(&bar[XB_XCNT(j)]); sum += c; cnt += (c > 0u) ? 1u : 0u; mine = (j == x) ? c : mine; }
        if (sum == G) break;
        __builtin_amdgcn_s_sleep(1);
        if ((++sp & 255u) == 0u) { if (xb_ld(&bar[XB_TMO])) break; if (sp > XB_SPIN_CAP) { atomicAdd(&bar[XB_TMO], 1u); break; } }
    }
    nloc = mine > 0u ? mine : 1u; nx = cnt > 0u ? cnt : 1u;
}

__device__ __forceinline__ void xcd_barrier(const XcdBarrier& b) {
    asm volatile("s_waitcnt vmcnt(0)" ::: "memory");
    __syncthreads();
    if (threadIdx.x == 0) {
        unsigned* bar = b.bar;
        __builtin_amdgcn_s_waitcnt(0);
        unsigned nloc = b.st[0], nx = b.st[1];
        if (nloc == 0u) { xcd_barrier_complete(bar, b.x, nloc, nx); b.st[0] = nloc; b.st[1] = nx; }
        const unsigned old = xb_add(&bar[XB_XSUB(b.x)], 1u);
        const unsigned gen = old / nloc;
        if (old + 1u == (gen + 1u) * nloc) {
            __builtin_amdgcn_fence(__ATOMIC_RELEASE, "agent");
            asm volatile("s_waitcnt vmcnt(0)" ::: "memory");
            const unsigned og = xb_add(&bar[XB_TOP], 1u);
            const unsigned tg = og / nx;
            if (og + 1u == (tg + 1u) * nx) xb_add(&bar[XB_TOPGEN], 1u);
            else XB_SPIN(xb_ld(&bar[XB_TOPGEN]) == tg, bar);
            __builtin_amdgcn_fence(__ATOMIC_ACQUIRE, "agent");
            xb_add(&bar[XB_XGEN(b.x)], 1u);
            asm volatile("s_waitcnt vmcnt(0)" ::: "memory");
        } else {
            XB_SPIN(xb_ld(&bar[XB_XGEN(b.x)]) == gen, bar);
            __builtin_amdgcn_fence(__ATOMIC_ACQUIRE, "agent");
            asm volatile("s_waitcnt vmcnt(0)" ::: "memory");
        }
    }
    __syncthreads();
}
struct Args { const float* in[31]; float* out; unsigned char* ws; int ph_lo, ph_hi; };
struct Frame {
    LAS unsigned char* lds;
    volatile LAS unsigned* MISC;
    gu32* ctl;
    int tid, lane, wave;
    int vcu, G;
    float* out; unsigned char* ws;
};
__device__ __forceinline__ float wave_sum(float v) {
#pragma unroll
    for (int o = 1; o < 64; o <<= 1) v += __shfl_xor(v, o);
    return v;
}
__device__ __forceinline__ float wave_max(float v) {
#pragma unroll
    for (int o = 1; o < 64; o <<= 1) v = fmaxf(v, __shfl_xor(v, o));
    return v;
}
__device__ __forceinline__ float silu_f(float g) { return g / (1.0f + __expf(-g)); }
__device__ __forceinline__ float sigm_f(float g) { return 1.0f / (1.0f + __expf(-g)); }
__device__ __forceinline__ const float* xin_row(const float* xp, const float* xs, int m) { return m < MP ? xp + (size_t)m * D : xs + (size_t)(m - MP) * D; }

__device__ __forceinline__ void tr_item(const float* W, int ldw, int n0, int nvalid, int k0, bf16* WT, int ldk, int drow0, LAS float* scr, int lane) {
    const int c = lane & 31;
#pragma unroll 8
    for (int i = 0; i < 32; ++i) { const int kk = 2 * i + (lane >> 5); scr[kk * 33 + c] = (c < nvalid) ? W[(size_t)(k0 + kk) * ldw + n0 + c] : 0.f; }
    LDS_WAIT(); asm volatile("" ::: "memory");
    const int c8 = lane & 7;
#pragma unroll
    for (int j = 0; j < 4; ++j) { const int n = (lane >> 3) + 8 * j; const LAS float* s = scr + (8 * c8) * 33 + n;
        v4u o; o.x = pk2(s[0 * 33], s[1 * 33]); o.y = pk2(s[2 * 33], s[3 * 33]); o.z = pk2(s[4 * 33], s[5 * 33]); o.w = pk2(s[6 * 33], s[7 * 33]);
        if (n < nvalid) *(GAS v4u*)(WT + (size_t)(drow0 + n) * ldk + k0 + 8 * c8) = o; }
    LDS_WAIT(); asm volatile("" ::: "memory");
}
__device__ __forceinline__ void tr_plain(const float* W, int K, int N, bf16* WT, int item, LAS float* scr, int lane) {
    const int nblk = N / 32, kb = item / nblk, nb = item % nblk;
    tr_item(W, N, 32 * nb, 32, 64 * kb, WT, K, 32 * nb, scr, lane);
}
__device__ __forceinline__ void tr_gu(const float* W, bf16* WT, int up, int item, LAS float* scr, int lane) {
    const int nblk = FF / 32, kb = item / nblk, nb = item % nblk, c0 = 32 * nb;
    tr_item(W, FF, c0, 32, 64 * kb, WT, D, 256 * (c0 >> 7) + (c0 & 127) + up * 128, scr, lane);
}
__device__ __forceinline__ void tr_win(const float* W, bf16* WT, int item, LAS float* scr, int lane) {
    const int nblk = 89, kb = item / nblk, nb = item % nblk;
    int n0, nv, d0;
    if (nb < 64) { n0 = 32 * nb; nv = 32; d0 = n0; } else if (nb == 64) { n0 = 2048; nv = 8; d0 = 2816; } else { n0 = 2056 + 32 * (nb - 65); nv = 32; d0 = 2048 + 32 * (nb - 65); }
    tr_item(W, NIN, n0, nv, 64 * kb, WT, D, d0, scr, lane);
}
__device__ __forceinline__ void rms_row_to_bf16(const float* xrow, const float* gain, bf16* orow, int lane) {
    const GAS f32x4* xr = (const GAS f32x4*)xrow + lane; const GAS f32x4* gr = (const GAS f32x4*)gain + lane;
    f32x4 v[4]; float s = 0.f;
#pragma unroll
    for (int j = 0; j < 4; ++j) { v[j] = xr[64 * j]; s += (v[j].x * v[j].x + v[j].y * v[j].y) + (v[j].z * v[j].z + v[j].w * v[j].w); }
    const float r = 1.0f / sqrtf(wave_sum(s) * (1.f / D) + EPS);
    GAS v2u* o8 = (GAS v2u*)orow + lane;
#pragma unroll
    for (int j = 0; j < 4; ++j) { const f32x4 g = gr[64 * j]; v2u o; o.x = pk2(v[j].x * r * g.x, v[j].y * r * g.y); o.y = pk2(v[j].z * r * g.z, v[j].w * r * g.w); o8[64 * j] = o; }
}
__device__ __forceinline__ void p0_prologue(Frame& F, const Args& A) {
    LAS float* scr = (LAS float*)(F.lds + RING_OFF + F.wave * 16384);
    const int gw = F.vcu * NWAVES + F.wave, NGW = F.G * NWAVES;
    bf16* WGU1 = (bf16*)(F.ws + WS_WGU1); bf16* WD1 = (bf16*)(F.ws + WS_WD1); bf16* WIN = (bf16*)(F.ws + WS_WIN); bf16* WOUT = (bf16*)(F.ws + WS_WOUT);
    bf16* WGU2 = (bf16*)(F.ws + WS_WGU2); bf16* WD2 = (bf16*)(F.ws + WS_WD2); bf16* WPG = (bf16*)(F.ws + WS_WPG); bf16* WPP = (bf16*)(F.ws + WS_WPP);
    constexpr int I_GU = (D / 64) * (FF / 32), I_DN = (FF / 64) * (D / 32), I_IN = (D / 64) * 89, I_SQ = (D / 64) * (D / 32), I_PP = (PLE / 64) * (D / 32);
    constexpr int NITEMS = 4 * I_GU + 2 * I_DN + I_IN + 2 * I_SQ + I_PP;
    for (int it = gw; it < NITEMS; it += NGW) {
        int r = it;
        if (r < I_GU) { tr_gu(A.in[11], WGU1, 0, r, scr, F.lane); continue; } r -= I_GU;
        if (r < I_GU) { tr_gu(A.in[12], WGU1, 1, r, scr, F.lane); continue; } r -= I_GU;
        if (r < I_DN) { tr_plain(A.in[13], FF, D, WD1, r, scr, F.lane); continue; } r -= I_DN;
        if (r < I_IN) { tr_win(A.in[16], WIN, r, scr, F.lane); continue; } r -= I_IN;
        if (r < I_SQ) { tr_plain(A.in[22], D, D, WOUT, r, scr, F.lane); continue; } r -= I_SQ;
        if (r < I_GU) { tr_gu(A.in[25], WGU2, 0, r, scr, F.lane); continue; } r -= I_GU;
        if (r < I_GU) { tr_gu(A.in[26], WGU2, 1, r, scr, F.lane); continue; } r -= I_GU;
        if (r < I_DN) { tr_plain(A.in[27], FF, D, WD2, r, scr, F.lane); continue; } r -= I_DN;
        if (r < I_SQ) { tr_plain(A.in[28], D, D, WPG, r, scr, F.lane); continue; } r -= I_SQ;
        tr_plain(A.in[29], PLE, D, WPP, r, scr, F.lane);
    }
    for (int rr = gw; rr < LDC - NIN; rr += NGW) { GAS v4u* o = (GAS v4u*)(WIN + (size_t)(NIN + rr) * D) + F.lane; o[0] = (v4u){0, 0, 0, 0}; o[64] = (v4u){0, 0, 0, 0}; }
    bf16* HB = (bf16*)(F.ws + WS_HBUF); bf16* PB = (bf16*)(F.ws + WS_PBUF);
    for (int m = gw; m < M; m += NGW) {
        rms_row_to_bf16(xin_row(A.in[0], A.in[1], m), A.in[9], HB + (size_t)m * D, F.lane);
        const float* prow = m < MP ? A.in[6] + (size_t)m * PLE : A.in[7] + (size_t)(m - MP) * PLE;
        const f32x4 pv = ((const GAS f32x4*)prow)[F.lane]; v2u o; o.x = pk2(pv.x, pv.y); o.y = pk2(pv.z, pv.w); ((GAS v2u*)(PB + (size_t)m * PLE))[F.lane] = o;
    }
}
template <int HMODE, bool BASE_IN>
__device__ __forceinline__ void resid_pass(Frame& F, const float* xp, const float* xs, const bf16* src, float scale, const float* gpost, const float* g2, bf16* hout) {
    const int gw = F.vcu * NWAVES + F.wave, NGW = F.G * NWAVES;
    for (int m = gw; m < M; m += NGW) {
        const GAS v2u* sr = (const GAS v2u*)(src + (size_t)m * D) + F.lane;
        const float* brow = BASE_IN ? xin_row(xp, xs, m) : F.out + (size_t)m * D;
        const GAS f32x4* br = (const GAS f32x4*)brow + F.lane; const GAS f32x4* gp = (const GAS f32x4*)gpost + F.lane;
        f32x4 v[4], b[4]; float s = 0.f;
#pragma unroll
        for (int j = 0; j < 4; ++j) { const v2u w = sr[64 * j]; v[j] = (f32x4){bflo(w.x), bfhi(w.x), bflo(w.y), bfhi(w.y)}; b[j] = br[64 * j];
            s += (v[j].x * v[j].x + v[j].y * v[j].y) + (v[j].z * v[j].z + v[j].w * v[j].w); }
        const float r = scale / sqrtf(wave_sum(s) * (1.f / D) + EPS);
        float s2 = 0.f;
        GAS f32x4* orow = (GAS f32x4*)(F.out + (size_t)m * D) + F.lane;
#pragma unroll
        for (int j = 0; j < 4; ++j) { const f32x4 g = gp[64 * j]; v[j] = b[j] + v[j] * r * g; orow[64 * j] = v[j];
            s2 += (v[j].x * v[j].x + v[j].y * v[j].y) + (v[j].z * v[j].z + v[j].w * v[j].w); }
        if constexpr (HMODE == 1) {
            const float r2 = 1.0f / sqrtf(wave_sum(s2) * (1.f / D) + EPS); const GAS f32x4* g2r = (const GAS f32x4*)g2 + F.lane; GAS v2u* o8 = (GAS v2u*)(hout + (size_t)m * D) + F.lane;
#pragma unroll
            for (int j = 0; j < 4; ++j) { const f32x4 g = g2r[64 * j]; v2u o; o.x = pk2(v[j].x * r2 * g.x, v[j].y * r2 * g.y); o.y = pk2(v[j].z * r2 * g.z, v[j].w * r2 * g.w); o8[64 * j] = o; }
        } else if constexpr (HMODE == 2) {
            GAS v2u* o8 = (GAS v2u*)(hout + (size_t)m * D) + F.lane;
#pragma unroll
            for (int j = 0; j < 4; ++j) { v2u o; o.x = pk2(v[j].x, v[j].y); o.y = pk2(v[j].z, v[j].w); o8[64 * j] = o; }
        }
    }
}
__device__ __forceinline__ int t5_bucket(int d) {
    if (d < 16) return d;
    return 16 + (d >= 19) + (d >= 21) + (d >= 24) + (d >= 27) + (d >= 31) + (d >= 35) + (d >= 40) + (d >= 46) + (d >= 52) + (d >= 59) + (d >= 67) + (d >= 77) + (d >= 87) + (d >= 99) + (d >= 113);
}
__device__ __forceinline__ float softplus_f(float x) { return x > 20.f ? x : log1pf(__expf(x)); }

__device__ __forceinline__ void gdn_naive_item(Frame& F, const Args& A, bool prompt, int sidx, int h) {
    const bf16* cols = (const bf16*)(F.ws + WS_BIG); bf16* mix = (bf16*)(F.ws + WS_MIXIN);
    LAS float* ybuf = (LAS float*)(F.lds + RING_OFF);
    LAS float* red = ybuf + 384;
    LAS float* pa = ybuf + 512;
    LAS float* pb = pa + 512;
    LAS float* red2 = pb + 512;
    const int tid = F.tid, part = tid >> 7, dv = tid & 127, lane = F.lane, wave = F.wave;
    const int T = prompt ? SEQ : DECT, row0 = prompt ? sidx * SEQ : MP + sidx * DECT;
    float S[32];
    if (prompt) {
#pragma unroll
        for (int i = 0; i < 32; ++i) S[i] = 0.f;
    } else {
        const float* s0 = A.in[3] + ((size_t)(sidx * 4 + h) * 128 + part * 32) * 128 + dv;
#pragma unroll
        for (int i = 0; i < 32; ++i) S[i] = s0[(size_t)i * 128];
    }
    const int ch = tid, kind = ch >> 7, col = kind * 512 + h * 128 + (ch & 127);
    float w0 = 0.f, w1 = 0.f, w2 = 0.f, w3 = 0.f, r0 = 0.f, r1 = 0.f, r2 = 0.f;
    if (tid < 384) { const float* cw = A.in[17]; w0 = cw[col]; w1 = cw[1536 + col]; w2 = cw[2 * 1536 + col]; w3 = cw[3 * 1536 + col];
        if (!prompt) { const float* sc = A.in[2] + (size_t)sidx * 3 * 1536; r0 = sc[col]; r1 = sc[1536 + col]; r2 = sc[2 * 1536 + col]; } }
    const float Aneg = -__expf(A.in[18][h]), dtb = A.in[19][h], gain = A.in[20][dv];
    for (int t = 0; t < T; ++t) {
        const bf16* crow = cols + (size_t)(row0 + t) * LDC;
        if (tid < 384) {
            const float x = bf2f(crow[col]); float y = r0 * w0 + r1 * w1 + r2 * w2 + x * w3; r0 = r1; r1 = r2; r2 = x;
            y = silu_f(y); ybuf[ch] = y; const float sq = wave_sum(y * y); if (lane == 0) red[wave] = sq;
        }
        __syncthreads();
        const float rq = 0.08838834764831845f / sqrtf(red[0] + red[1] + 1e-6f), rk = 1.0f / sqrtf(red[2] + red[3] + 1e-6f);
        const float bb = bf2f(crow[C_B + h]), aa = bf2f(crow[C_A + h]);
        const float beta = sigm_f(bb), g = Aneg * softplus_f(aa + dtb), a = __expf(g);
        float ks = 0.f;
#pragma unroll
        for (int i = 0; i < 32; ++i) ks += ybuf[128 + part * 32 + i] * S[i];
        pa[part * 128 + dv] = ks;
        __syncthreads();
        const float kst = ((pa[dv] + pa[128 + dv]) + (pa[256 + dv] + pa[384 + dv])) * rk;
        const float vnew = beta * (ybuf[256 + dv] - a * kst);
        float op = 0.f;
#pragma unroll
        for (int i = 0; i < 32; ++i) { const float kk = ybuf[128 + part * 32 + i] * rk; S[i] = a * S[i] + kk * vnew; op += ybuf[part * 32 + i] * S[i]; }
        pb[part * 128 + dv] = op * rq;
        __syncthreads();
        const float o = (pb[dv] + pb[128 + dv]) + (pb[256 + dv] + pb[384 + dv]);
        if (tid < 128) { const float sq = wave_sum(o * o); if (lane == 0) red2[wave] = sq; }
        __syncthreads();
        if (tid < 128) { const float rn = 1.0f / sqrtf((red2[0] + red2[1]) * (1.f / 128.f) + EPS); const float zz = bf2f(crow[C_Z + h * 128 + dv]);
            mix[(size_t)(row0 + t) * D + h * 128 + dv] = (bf16)f2bf(o * rn * gain * silu_f(zz)); }
    }
    float* so = F.out + (prompt ? O_GDNP : O_GDNS) + ((size_t)(sidx * 4 + h) * 128 + part * 32) * 128 + dv;
#pragma unroll
    for (int i = 0; i < 32; ++i) so[(size_t)i * 128] = S[i];
    __syncthreads();
}

__device__ __forceinline__ void swa_scores(Frame& F, const Args& A, const bf16* cols, bool prompt, int b, int t, int s, int qi, int kh, int hf, LAS float* qs, float (&sc)[4]) {
    const int w = F.lane + 64 * hf, dist = 127 - w;
    bool valid = true; const bf16* kb = cols; const float* kf = nullptr;
    if (prompt) { const int pos = t - dist; valid = pos >= 0; kb = cols + (size_t)(b * SEQ + (valid ? pos : 0)) * LDC + C_KS + kh * 64; }
    else { const int j = qi + 1 + w; if (j < 128) kf = A.in[4] + ((size_t)(s * 128 + j) * 2 + kh) * 64; else kb = cols + (size_t)(MP + s * DECT + (j - 128)) * LDC + C_KS + kh * 64; }
    float a0 = 0.f, a1 = 0.f, a2 = 0.f, a3 = 0.f;
#pragma unroll 1
    for (int d4 = 0; d4 < 16; ++d4) {
        float k0, k1, k2, k3;
        if (kf) { const f32x4 x0 = ((const GAS f32x4*)kf)[d4]; k0 = x0.x; k1 = x0.y; k2 = x0.z; k3 = x0.w; }
        else { const v2u x = ((const GAS v2u*)kb)[d4]; k0 = bflo(x.x); k1 = bfhi(x.x); k2 = bflo(x.y); k3 = bfhi(x.y); }
        const LAS f32x4* q4 = (const LAS f32x4*)qs + d4;
        const f32x4 q0 = q4[0], q1 = q4[16], q2 = q4[32], q3 = q4[48];
        a0 += q0.x * k0 + q0.y * k1 + q0.z * k2 + q0.w * k3; a1 += q1.x * k0 + q1.y * k1 + q1.z * k2 + q1.w * k3;
        a2 += q2.x * k0 + q2.y * k1 + q2.z * k2 + q2.w * k3; a3 += q3.x * k0 + q3.y * k1 + q3.z * k2 + q3.w * k3;
    }
    const int bk = t5_bucket(dist); const float* rb = A.in[8] + bk * 8 + kh * 4;
    sc[0] = valid ? a0 + rb[0] : -INFINITY; sc[1] = valid ? a1 + rb[1] : -INFINITY; sc[2] = valid ? a2 + rb[2] : -INFINITY; sc[3] = valid ? a3 + rb[3] : -INFINITY;
}
__device__ __forceinline__ void swa_item(Frame& F, const Args& A, int m, int kh, LAS float* qs, LAS float* ps) {
    const bf16* cols = (const bf16*)(F.ws + WS_BIG); bf16* mix = (bf16*)(F.ws + WS_MIXIN);
    const int lane = F.lane; const bool prompt = m < MP;
    const int b = prompt ? m / SEQ : 0, t = prompt ? m % SEQ : 0, s = prompt ? 0 : (m - MP) / DECT, qi = prompt ? 0 : (m - MP) % DECT;
    const bf16* qrow = cols + (size_t)m * LDC + C_QS + kh * 256;
#pragma unroll
    for (int g = 0; g < 4; ++g) qs[g * 64 + lane] = bf2f(qrow[g * 64 + lane]) * 0.125f;
    LDS_WAIT(); asm volatile("" ::: "memory");
    float sc[2][4];
    swa_scores(F, A, cols, prompt, b, t, s, qi, kh, 0, qs, sc[0]);
    swa_scores(F, A, cols, prompt, b, t, s, qi, kh, 1, qs, sc[1]);
#pragma unroll
    for (int g = 0; g < 4; ++g) {
        const float sink = A.in[21][kh * 4 + g];
        const float mx = fmaxf(wave_max(fmaxf(sc[0][g], sc[1][g])), sink);
        const float e0 = __expf(sc[0][g] - mx), e1 = __expf(sc[1][g] - mx);
        const float den = wave_sum(e0 + e1) + __expf(sink - mx), inv = 1.0f / den;
        ps[g * 128 + lane] = e0 * inv; ps[g * 128 + 64 + lane] = e1 * inv;
    }
    LDS_WAIT(); asm volatile("" ::: "memory");
    float o0 = 0.f, o1 = 0.f, o2 = 0.f, o3 = 0.f;
    const int wlo = prompt ? (t >= 127 ? 0 : 127 - t) : 0;
#pragma unroll 2
    for (int w = wlo; w < 128; ++w) {
        float v;
        if (prompt) v = bf2f(cols[(size_t)(b * SEQ + t - 127 + w) * LDC + C_VS + kh * 64 + lane]);
        else { const int j = qi + 1 + w; v = j < 128 ? A.in[5][((size_t)(s * 128 + j) * 2 + kh) * 64 + lane] : bf2f(cols[(size_t)(MP + s * DECT + (j - 128)) * LDC + C_VS + kh * 64 + lane]); }
        o0 += ps[w] * v; o1 += ps[128 + w] * v; o2 += ps[256 + w] * v; o3 += ps[384 + w] * v;
    }
    bf16* orow = mix + (size_t)m * D + 512 + kh * 256;
    orow[lane] = (bf16)f2bf(o0); orow[64 + lane] = (bf16)f2bf(o1); orow[128 + lane] = (bf16)f2bf(o2); orow[192 + lane] = (bf16)f2bf(o3);
    LDS_WAIT(); asm volatile("" ::: "memory");
}

constexpr size_t WS_GW = WS_HBUF, WS_GU = WS_HBUF + 16 * MiB, WS_GQD = WS_TMP, WS_GKD = WS_TMP + 16 * MiB, WS_GQK = WS_WGU1, WS_GCD = WS_WGU1 + 8 * MiB;
constexpr int NCH = 128;
typedef short bf16x8 __attribute__((ext_vector_type(8)));
__device__ __forceinline__ unsigned cvtpk(float lo, float hi) { return pg8::cvt_pk_bf16(lo, hi); }

__device__ __forceinline__ void gdn_prep_item(Frame& F, const Args& A, int b, int n, int h) {
    const bf16* cols = (const bf16*)(F.ws + WS_BIG);
    const int ch = (b * NCH + n) * 4 + h, tid = F.tid, lane = F.lane, wave = F.wave;
    bf16* WN = (bf16*)(F.ws + WS_GW) + (size_t)ch * 8192; bf16* UT = (bf16*)(F.ws + WS_GU) + (size_t)ch * 8192;
    bf16* QD = (bf16*)(F.ws + WS_GQD) + (size_t)ch * 8192; bf16* KDT = (bf16*)(F.ws + WS_GKD) + (size_t)ch * 8192;
    bf16* QK = (bf16*)(F.ws + WS_GQK) + (size_t)ch * 4096; float* CD = (float*)(F.ws + WS_GCD);
    LAS float* Lm = (LAS float*)(F.lds + 0);
    LAS float* SC = (LAS float*)(F.lds + 17408);
    LAS bf16* Kb = (LAS bf16*)(F.lds + 18432);
    LAS bf16* Qb = (LAS bf16*)(F.lds + 35840);
    LAS float* RHS = (LAS float*)(F.lds + 53248);
    const int r0 = b * SEQ + n * 64;
    if (wave == 0) {
        const bf16* crow = cols + (size_t)(r0 + lane) * LDC;
        const float bb = bf2f(crow[C_B + h]), aa = bf2f(crow[C_A + h]);
        const float beta = sigm_f(bb), g = -__expf(A.in[18][h]) * softplus_f(aa + A.in[19][h]);
        float gc = g;
#pragma unroll
        for (int o = 1; o < 64; o <<= 1) { const float t = __shfl_up(gc, o); if (lane >= o) gc += t; }
        const float gl = __shfl(gc, 63);
        SC[lane] = beta; SC[64 + lane] = gc; SC[128 + lane] = __expf(gc); SC[192 + lane] = __expf(gl - gc);
        if (lane == 0) CD[ch] = __expf(gl);
    }
    __syncthreads();
    {
        const int gi = tid & 15, cbase = tid >> 4;
#pragma unroll
        for (int it = 0; it < 6; ++it) {
            const int kind = it >> 1, c = (it & 1) * 32 + cbase, col0 = kind * 512 + h * 128 + gi * 8;
            float y[8];
#pragma unroll
            for (int e = 0; e < 8; ++e) y[e] = 0.f;
#pragma unroll
            for (int j = 0; j < 4; ++j) {
                const int tt = n * 64 + c - 3 + j;
                if (tt >= 0) {
                    const v4u x = *(const GAS v4u*)(cols + (size_t)(b * SEQ + tt) * LDC + col0);
                    const f32x4 w0 = *(const GAS f32x4*)(A.in[17] + j * 1536 + col0), w1 = *(const GAS f32x4*)(A.in[17] + j * 1536 + col0 + 4);
                    y[0] += bflo(x.x) * w0.x; y[1] += bfhi(x.x) * w0.y; y[2] += bflo(x.y) * w0.z; y[3] += bfhi(x.y) * w0.w;
                    y[4] += bflo(x.z) * w1.x; y[5] += bfhi(x.z) * w1.y; y[6] += bflo(x.w) * w1.z; y[7] += bfhi(x.w) * w1.w;
                }
            }
            float ss = 0.f;
#pragma unroll
            for (int e = 0; e < 8; ++e) { y[e] = silu_f(y[e]); ss += y[e] * y[e]; }
            ss += __shfl_xor(ss, 1); ss += __shfl_xor(ss, 2); ss += __shfl_xor(ss, 4); ss += __shfl_xor(ss, 8);
            const float beta = SC[c], egc = SC[128 + c], ekd = SC[192 + c];
            if (kind == 0) {
                const float rn = 0.08838834764831845f / sqrtf(ss + 1e-6f);
                v4u o; o.x = cvtpk(y[0] * rn, y[1] * rn); o.y = cvtpk(y[2] * rn, y[3] * rn); o.z = cvtpk(y[4] * rn, y[5] * rn); o.w = cvtpk(y[6] * rn, y[7] * rn);
                *(LAS v4u*)(Qb + c * 136 + gi * 8) = o;
                const float rd = rn * egc;
                v4u d; d.x = cvtpk(y[0] * rd, y[1] * rd); d.y = cvtpk(y[2] * rd, y[3] * rd); d.z = cvtpk(y[4] * rd, y[5] * rd); d.w = cvtpk(y[6] * rd, y[7] * rd);
                *(GAS v4u*)(QD + c * 128 + gi * 8) = d;
            } else if (kind == 1) {
                const float rn = 1.0f / sqrtf(ss + 1e-6f);
                v4u o; o.x = cvtpk(y[0] * rn, y[1] * rn); o.y = cvtpk(y[2] * rn, y[3] * rn); o.z = cvtpk(y[4] * rn, y[5] * rn); o.w = cvtpk(y[6] * rn, y[7] * rn);
                *(LAS v4u*)(Kb + c * 136 + gi * 8) = o;
                const float rr = rn * beta * egc, rk = rn * ekd;
                LAS float* rp = RHS + c * 256 + 128 + gi * 8;
                *(LAS f32x4*)rp = (f32x4){y[0] * rr, y[1] * rr, y[2] * rr, y[3] * rr}; *(LAS f32x4*)(rp + 4) = (f32x4){y[4] * rr, y[5] * rr, y[6] * rr, y[7] * rr};
#pragma unroll
                for (int e = 0; e < 8; ++e) KDT[(gi * 8 + e) * 64 + c] = (bf16)f2bf(y[e] * rk);
            } else {
                LAS float* rp = RHS + c * 256 + gi * 8;
                *(LAS f32x4*)rp = (f32x4){y[0] * beta, y[1] * beta, y[2] * beta, y[3] * beta}; *(LAS f32x4*)(rp + 4) = (f32x4){y[4] * beta, y[5] * beta, y[6] * beta, y[7] * beta};
            }
        }
    }
    __syncthreads();
    {
        const int kind = wave >> 2, mt = wave & 3, g = lane >> 4, rr = lane & 15;
        const LAS bf16* Am = kind ? Qb : Kb;
#pragma unroll
        for (int nt = 0; nt < 4; ++nt) {
            f32x4 acc = (f32x4){0.f, 0.f, 0.f, 0.f};
            if (nt <= mt) {
#pragma unroll
                for (int s = 0; s < 4; ++s) {
                    const bf16x8 a = *(const LAS bf16x8*)(Am + (16 * mt + rr) * 136 + 32 * s + 8 * g);
                    const bf16x8 bq = *(const LAS bf16x8*)(Kb + (16 * nt + rr) * 136 + 32 * s + 8 * g);
                    acc = __builtin_amdgcn_mfma_f32_16x16x32_bf16(a, bq, acc, 0, 0, 0);
                }
            }
            const int j = 16 * nt + rr; const float gcj = SC[64 + j];
#pragma unroll
            for (int r = 0; r < 4; ++r) {
                const int i = 16 * mt + 4 * g + r; const float dec = __expf(fminf(SC[64 + i] - gcj, 0.f));
                if (kind == 0) { Lm[i * 68 + j] = (i > j) ? acc[r] * SC[i] * dec : 0.f; }
                else { QK[i * 64 + j] = (bf16)f2bf((i >= j) ? acc[r] * dec : 0.f); }
            }
        }
    }
    __syncthreads();
    if (tid < 256) {
        float x[64];
#pragma unroll
        for (int i = 0; i < 64; ++i) {
            float s = RHS[i * 256 + tid];
#pragma unroll
            for (int j = 0; j < i; ++j) s -= Lm[i * 68 + j] * x[j];
            x[i] = s;
            if ((i & 3) == 3) asm volatile("" ::: "memory");
        }
        if (tid < 128) {
#pragma unroll
            for (int q = 0; q < 8; ++q) { v4u o; o.x = cvtpk(x[8 * q], x[8 * q + 1]); o.y = cvtpk(x[8 * q + 2], x[8 * q + 3]); o.z = cvtpk(x[8 * q + 4], x[8 * q + 5]); o.w = cvtpk(x[8 * q + 6], x[8 * q + 7]);
                *(GAS v4u*)(UT + tid * 64 + 8 * q) = o; }
        } else {
#pragma unroll
            for (int i = 0; i < 64; ++i) WN[i * 128 + (tid - 128)] = (bf16)f2bf(-x[i]);
        }
    }
    __syncthreads();
}

__device__ __forceinline__ bf16x8 ld_afrag(const bf16* X, int ld, int mt, int s, int g, int rr) {
    const bf16* p = X + (size_t)(16 * mt + rr) * ld + 32 * s + 4 * g;
    const v2u a = *(const GAS v2u*)p, b = *(const GAS v2u*)(p + 16);
    const v4u w = (v4u){a.x, a.y, b.x, b.y};
    return __builtin_bit_cast(bf16x8, w);
}
__device__ __forceinline__ bf16x8 pack_bfrag(const f32x4& t0, const f32x4& t1) {
    const v4u w = (v4u){cvtpk(t0[0], t0[1]), cvtpk(t0[2], t0[3]), cvtpk(t1[0], t1[1]), cvtpk(t1[2], t1[3])};
    return __builtin_bit_cast(bf16x8, w);
}
__device__ __forceinline__ void gdn_scan_wave(Frame& F, int b, int h, int sl) {
    const int lane = F.lane, g = lane >> 4, rr = lane & 15;
    bf16* mix = (bf16*)(F.ws + WS_MIXIN);
    const float* CD = (const float*)(F.ws + WS_GCD);
    f32x4 S[8];
#pragma unroll
    for (int t = 0; t < 8; ++t) S[t] = (f32x4){0.f, 0.f, 0.f, 0.f};
    for (int n = 0; n < NCH; ++n) {
        const int ch = (b * NCH + n) * 4 + h;
        const bf16* WN = (const bf16*)(F.ws + WS_GW) + (size_t)ch * 8192; const bf16* UT = (const bf16*)(F.ws + WS_GU) + (size_t)ch * 8192;
        const bf16* QD = (const bf16*)(F.ws + WS_GQD) + (size_t)ch * 8192; const bf16* KDT = (const bf16*)(F.ws + WS_GKD) + (size_t)ch * 8192;
        const bf16* QK = (const bf16*)(F.ws + WS_GQK) + (size_t)ch * 4096;
        const float cd = CD[ch];
        bf16x8 Sb[4];
#pragma unroll
        for (int s = 0; s < 4; ++s) Sb[s] = pack_bfrag(S[2 * s], S[2 * s + 1]);
        f32x4 vt[4], ot[4];
#pragma unroll
        for (int mt = 0; mt < 4; ++mt) {
            const v2u u = *(const GAS v2u*)(UT + (size_t)(16 * sl + rr) * 64 + 16 * mt + 4 * g);
            vt[mt] = (f32x4){bflo(u.x), bfhi(u.x), bflo(u.y), bfhi(u.y)}; ot[mt] = (f32x4){0.f, 0.f, 0.f, 0.f};
#pragma unroll
            for (int s = 0; s < 4; ++s) {
                vt[mt] = __builtin_amdgcn_mfma_f32_16x16x32_bf16(ld_afrag(WN, 128, mt, s, g, rr), Sb[s], vt[mt], 0, 0, 0);
                ot[mt] = __builtin_amdgcn_mfma_f32_16x16x32_bf16(ld_afrag(QD, 128, mt, s, g, rr), Sb[s], ot[mt], 0, 0, 0);
            }
        }
        bf16x8 vb[2];
        vb[0] = pack_bfrag(vt[0], vt[1]); vb[1] = pack_bfrag(vt[2], vt[3]);
#pragma unroll
        for (int mt = 0; mt < 4; ++mt)
#pragma unroll
            for (int s = 0; s < 2; ++s) ot[mt] = __builtin_amdgcn_mfma_f32_16x16x32_bf16(ld_afrag(QK, 64, mt, s, g, rr), vb[s], ot[mt], 0, 0, 0);
#pragma unroll
        for (int t = 0; t < 8; ++t) {
            S[t] = S[t] * cd;
#pragma unroll
            for (int s = 0; s < 2; ++s) S[t] = __builtin_amdgcn_mfma_f32_16x16x32_bf16(ld_afrag(KDT, 64, t, s, g, rr), vb[s], S[t], 0, 0, 0);
        }
        bf16* orow = mix + (size_t)(b * SEQ + n * 64) * D + h * 128 + 16 * sl + rr;
#pragma unroll
        for (int mt = 0; mt < 4; ++mt)
#pragma unroll
            for (int r = 0; r < 4; ++r) orow[(size_t)(16 * mt + 4 * g + r) * D] = (bf16)f2bf(ot[mt][r]);
    }
    float* so = F.out + O_GDNP + (size_t)(b * 4 + h) * 128 * 128 + 16 * sl + rr;
#pragma unroll
    for (int t = 0; t < 8; ++t)
#pragma unroll
        for (int r = 0; r < 4; ++r) so[(size_t)(16 * t + 4 * g + r) * 128] = S[t][r];
}
__device__ __forceinline__ void gdn_gate_pass(Frame& F, const Args& A) {
    const bf16* cols = (const bf16*)(F.ws + WS_BIG); bf16* mix = (bf16*)(F.ws + WS_MIXIN);
    const int gw = F.vcu * NWAVES + F.wave, NGW = F.G * NWAVES, lane = F.lane;
    const f32x4 g0 = *(const GAS f32x4*)(A.in[20] + (lane & 15) * 8), g1 = *(const GAS f32x4*)(A.in[20] + (lane & 15) * 8 + 4);
    for (int m = gw; m < MP; m += NGW) {
        bf16* p = mix + (size_t)m * D + lane * 8;
        const v4u x = *(const GAS v4u*)p; const v4u z = *(const GAS v4u*)(cols + (size_t)m * LDC + C_Z + lane * 8);
        float o[8] = {bflo(x.x), bfhi(x.x), bflo(x.y), bfhi(x.y), bflo(x.z), bfhi(x.z), bflo(x.w), bfhi(x.w)};
        const float zz[8] = {bflo(z.x), bfhi(z.x), bflo(z.y), bfhi(z.y), bflo(z.z), bfhi(z.z), bflo(z.w), bfhi(z.w)};
        float ss = 0.f;
#pragma unroll
        for (int e = 0; e < 8; ++e) ss += o[e] * o[e];
        ss += __shfl_xor(ss, 1); ss += __shfl_xor(ss, 2); ss += __shfl_xor(ss, 4); ss += __shfl_xor(ss, 8);
        const float rn = 1.0f / sqrtf(ss * (1.f / 128.f) + EPS);
        const float gg[8] = {g0.x, g0.y, g0.z, g0.w, g1.x, g1.y, g1.z, g1.w};
#pragma unroll
        for (int e = 0; e < 8; ++e) o[e] = o[e] * rn * gg[e] * silu_f(zz[e]);
        v4u w; w.x = cvtpk(o[0], o[1]); w.y = cvtpk(o[2], o[3]); w.z = cvtpk(o[4], o[5]); w.w = cvtpk(o[6], o[7]);
        *(GAS v4u*)p = w;
    }
}

__device__ __forceinline__ void gdn_prep_phase(Frame& F, const Args& A) {
    for (int it = blockIdx.x; it < NB * NCH * 4; it += F.G) { const int h = it & 3, n = (it >> 2) % NCH, b = it / (4 * NCH); gdn_prep_item(F, A, b, n, h); }
}
__device__ __forceinline__ void mixers_phase(Frame& F, const Args& A) {
    const bf16* cols = (const bf16*)(F.ws + WS_BIG);
    const int bx = (int)blockIdx.x;
    if (bx < 64) {
        if (F.wave == 0) gdn_scan_wave(F, (bx & 7) >> 2, bx & 3, bx >> 3);
        return;
    }
    const int wg = bx - 64, NWG = F.G - 64;
    for (int it = wg; it < DECB * 4; it += NWG) gdn_naive_item(F, A, false, it >> 2, it & 3);
    { LAS float* qs = (LAS float*)(F.lds + RING_OFF + F.wave * 16384); LAS float* ps = qs + 256;
      const int gw = wg * NWAVES + F.wave, NGW = NWG * NWAVES;
      for (int it = gw; it < M * 2; it += NGW) swa_item(F, A, it >> 1, it & 1, qs, ps); }
    { const int gt = wg * (NWAVES * 64) + F.tid, NT = NWG * NWAVES * 64;
      for (int i = gt; i < 2 * 3 * 1536; i += NT) { const int c = i % 1536, r = (i / 1536) % 3, b = i / (3 * 1536); F.out[O_CONVP + i] = bf2f(cols[(size_t)(b * SEQ + SEQ - 3 + r) * LDC + c]); }
      for (int i = gt; i < 2 * 128 * 128; i += NT) { const int c = i % 128, r = (i / 128) % 128, b = i / (128 * 128); const size_t ro = (size_t)(b * SEQ + SEQ - 128 + r) * LDC;
          F.out[O_KP + i] = bf2f(cols[ro + C_KS + c]); F.out[O_VP + i] = bf2f(cols[ro + C_VS + c]); }
      for (int i = gt; i < DECB * 3 * 1536; i += NT) { const int c = i % 1536, r = (i / 1536) % 3, s = i / (3 * 1536); F.out[O_CONVS + i] = bf2f(cols[(size_t)(MP + s * DECT + 1 + r) * LDC + c]); }
      for (int i = gt; i < DECB * 128 * 128; i += NT) { const int c = i % 128, j = (i / 128) % 128, s = i / (128 * 128);
          if (j < 124) { F.out[O_KS + i] = A.in[4][(size_t)(s * 128 + j + 4) * 128 + c]; F.out[O_VS + i] = A.in[5][(size_t)(s * 128 + j + 4) * 128 + c]; }
          else { const size_t ro = (size_t)(MP + s * DECT + (j - 124)) * LDC; F.out[O_KS + i] = bf2f(cols[ro + C_KS + c]); F.out[O_VS + i] = bf2f(cols[ro + C_VS + c]); } }
    }
}
__global__ void __launch_bounds__(NWAVES * 64, 2) mk_fwd(Args args) {
    extern __shared__ __attribute__((aligned(16))) unsigned char lds[];
    Frame F;
    F.lds = (LAS unsigned char*)lds;
    F.MISC = (volatile LAS unsigned*)(F.lds + MISC_OFF);
    F.tid = threadIdx.x; F.lane = F.tid & 63; F.wave = __builtin_amdgcn_readfirstlane(F.tid >> 6);
    F.G = gridDim.x; { const int bx = blockIdx.x; F.vcu = (F.G % 8 == 0) ? (bx % 8) * (F.G / 8) + bx / 8 : bx; }
    F.ws = args.ws; F.out = args.out; F.ctl = (gu32*)(args.ws + WS_CTL);
    for (int u = F.tid; u < (LDS_BYTES - LDSCTL_OFF) / 4; u += NWAVES * 64) ((LAS unsigned*)(F.lds + LDSCTL_OFF))[u] = 0u;
    __syncthreads();
    const int lo = args.ph_lo, hi = args.ph_hi;
    XcdBarrier bar; bar.bar = (unsigned*)(F.ctl + CW_BAR); bar.x = 0; bar.st = nullptr;
    if (hi - lo > 1 || DBG_STOP < 99) bar = xcd_barrier_post((unsigned*)(F.ctl + CW_BAR), F.MISC + 8);
#ifndef PH_MASK
#define PH_MASK 0xffffffffu
#endif
#define IN(k) (((PH_MASK >> (k)) & 1u) && lo <= (k) && (k) < hi && (k) <= DBG_STOP)
#define SEAM(k) do { if (IN(k) && IN((k) + 1)) xcd_barrier(bar); } while (0)
    bf16* HB = (bf16*)(F.ws + WS_HBUF); bf16* BIG = (bf16*)(F.ws + WS_BIG); bf16* TMP = (bf16*)(F.ws + WS_TMP); bf16* MIX = (bf16*)(F.ws + WS_MIXIN); bf16* PB = (bf16*)(F.ws + WS_PBUF);
    const int bx = (int)blockIdx.x;

    if (IN(0)) { p0_prologue(F, args); } SEAM(0);
    if (IN(1)) { pg8::Gemm g{HB, (const bf16*)(F.ws + WS_WGU1), M, 2 * FF, D}; pg8::StaticOrder S; S.init(M, 2 * FF, F.G, bx); pg8::EpiGen<1> E{BIG, FF, nullptr};
        pg8::gemm_phase<pg8::EpiGen<1>, pg8::StaticOrder, true, true>(F.lds + RING_OFF, g, S, E); } SEAM(1);
    if (IN(2)) { pg8::Gemm g{BIG, (const bf16*)(F.ws + WS_WD1), M, D, FF}; pg8::StaticOrder S; S.init(M, D, F.G, bx); pg8::EpiGen<0> E{TMP, D, nullptr};
        pg8::gemm_phase<pg8::EpiGen<0>, pg8::StaticOrder, true, true>(F.lds + RING_OFF, g, S, E); } SEAM(2);
    if (IN(3)) { resid_pass<1, true>(F, args.in[0], args.in[1], TMP, 0.5f, args.in[10], args.in[14], HB); } SEAM(3);
    if (IN(4)) { pg8::Gemm g{HB, (const bf16*)(F.ws + WS_WIN), M, LDC, D}; pg8::StaticOrder S; S.init(M, LDC, F.G, bx); pg8::EpiGen<0> E{BIG, LDC, nullptr};
        pg8::gemm_phase<pg8::EpiGen<0>, pg8::StaticOrder, true, true>(F.lds + RING_OFF, g, S, E); } SEAM(4);
    if (IN(5)) { gdn_prep_phase(F, args); } SEAM(5);
    if (IN(6)) { mixers_phase(F, args); } SEAM(6);
    if (IN(7)) { gdn_gate_pass(F, args); } SEAM(7);
    if (IN(8)) { pg8::Gemm g{MIX, (const bf16*)(F.ws + WS_WOUT), M, D, D}; pg8::StaticOrder S; S.init(M, D, F.G, bx); pg8::EpiGen<0> E{TMP, D, nullptr};
        pg8::gemm_phase<pg8::EpiGen<0>, pg8::StaticOrder, true, true>(F.lds + RING_OFF, g, S, E); } SEAM(8);
    if (IN(9)) { resid_pass<1, false>(F, nullptr, nullptr, TMP, 1.0f, args.in[15], args.in[23], HB); } SEAM(9);
    if (IN(10)) { pg8::Gemm g{HB, (const bf16*)(F.ws + WS_WGU2), M, 2 * FF, D}; pg8::StaticOrder S; S.init(M, 2 * FF, F.G, bx); pg8::EpiGen<1> E{BIG, FF, nullptr};
        pg8::gemm_phase<pg8::EpiGen<1>, pg8::StaticOrder, true, true>(F.lds + RING_OFF, g, S, E); } SEAM(10);
    if (IN(11)) { pg8::Gemm g{BIG, (const bf16*)(F.ws + WS_WD2), M, D, FF}; pg8::StaticOrder S; S.init(M, D, F.G, bx); pg8::EpiGen<0> E{TMP, D, nullptr};
        pg8::gemm_phase<pg8::EpiGen<0>, pg8::StaticOrder, true, true>(F.lds + RING_OFF, g, S, E); } SEAM(11);
    if (IN(12)) { resid_pass<2, false>(F, nullptr, nullptr, TMP, 0.5f, args.in[24], nullptr, HB); } SEAM(12);
    if (IN(13)) { pg8::Gemm g{HB, (const bf16*)(F.ws + WS_WPG), M, D, D}; pg8::StaticOrder S; S.init(M, D, F.G, bx); pg8::EpiGen<2> E{TMP, D, nullptr};
        pg8::gemm_phase<pg8::EpiGen<2>, pg8::StaticOrder, true, true>(F.lds + RING_OFF, g, S, E); } SEAM(13);
    if (IN(14)) { pg8::Gemm g{PB, (const bf16*)(F.ws + WS_WPP), M, D, PLE}; pg8::StaticOrder S; S.init(M, D, F.G, bx); pg8::EpiGen<3> E{MIX, D, TMP};
        pg8::gemm_phase<pg8::EpiGen<3>, pg8::StaticOrder, true, true>(F.lds + RING_OFF, g, S, E); } SEAM(14);
    if (IN(15)) { resid_pass<0, false>(F, nullptr, nullptr, MIX, 1.0f, args.in[30], nullptr, nullptr); }

#if DBG_STOP < 99
    xcd_barrier(bar);
    { const bf16* dsrc = (const bf16*)(F.ws + DBG_BUF); const size_t gt = (size_t)blockIdx.x * (NWAVES * 64) + F.tid, NT = (size_t)F.G * NWAVES * 64;
      if (DBG_LD > 0) for (size_t i = gt; i < (size_t)M * D; i += NT) F.out[i] = bf2f(dsrc[(i / D) * DBG_LD + (i % D)]);
      for (size_t i = (size_t)M * D + gt; i < O_END; i += NT) F.out[i] = 0.f; }
#endif
#undef IN
#undef SEAM
}

extern "C" void kernel_launch(void* const* d_in, const int* in_sizes, int n_in, void* d_out, int out_size, void* d_ws, size_t ws_size, hipStream_t stream) {
    static int grid = 0;
    if (grid == 0) {
        if (n_in != 31 || (size_t)out_size != O_END || ws_size < WS_END) { fprintf(stderr, "kernel_launch: unexpected shapes: n_in %d out %d ws %zu\n", n_in, out_size, ws_size); grid = -1; return; }
        int dev = 0, cus = 0, per_cu = 0;
        if (hipGetDevice(&dev) != hipSuccess || hipDeviceGetAttribute(&cus, hipDeviceAttributeMultiprocessorCount, dev) != hipSuccess) { grid = -1; return; }
        if (hipFuncSetAttribute((const void*)mk_fwd, hipFuncAttributeMaxDynamicSharedMemorySize, LDS_BYTES) != hipSuccess) { fprintf(stderr, "kernel_launch: hipFuncSetAttribute failed\n"); grid = -1; return; }
        if (hipOccupancyMaxActiveBlocksPerMultiprocessor(&per_cu, (const void*)mk_fwd, NWAVES * 64, LDS_BYTES) != hipSuccess || per_cu < 1) { fprintf(stderr, "kernel_launch: occupancy query says %d\n", per_cu); }
        (void)hipGetLastError();
        grid = cus;
    }
    if (grid < 0) return;
    (void)hipMemsetAsync((char*)d_ws + WS_CTL, 0, CTL_ZERO_BYTES, stream);
    Args a{};
    for (int i = 0; i < 31; ++i) a.in[i] = (const float*)d_in[i];
    a.out = (float*)d_out; a.ws = (unsigned char*)d_ws;
    constexpr int NL = MK_N_LAUNCHES;
    for (int li = 0; li < NL; ++li) {
        a.ph_lo = (NL == 1) ? 0 : li; a.ph_hi = (NL == 1) ? N_PHASES : li + 1;
        hipLaunchKernelGGL(mk_fwd, dim3(grid), dim3(NWAVES * 64), LDS_BYTES, stream, a);
    }
}
```

```cpp
#include <hip/hip_runtime.h>
#ifndef DBG_STOP
#define DBG_STOP 99
#endif
#ifndef DBG_TWICE
#define DBG_TWICE (-1)
#endif
#include <cstdio>
#include <cstdint>
namespace pg8 {
#define PG8_LAS __attribute__((address_space(3)))
typedef unsigned short bf16_t;
typedef short bf16x8 __attribute__((ext_vector_type(8)));
typedef float f32x4 __attribute__((ext_vector_type(4)));
typedef unsigned u32x4 __attribute__((ext_vector_type(4)));
constexpr int BM = 256, BK = 64, HALF = 128, HTB = HALF * BK * 2  , STAGE_BYTES = 8 * HTB, NXCD = 8, WGM = 8;

__host__ __device__ __forceinline__ int lds_byte(int r, int c) { const int st = (r >> 4) * 2 + (c >> 5), rr = r & 15, cc = c & 31, ob = rr * 64 + cc * 2; return st * 1024 + (ob ^ (((ob >> 9) & 1) << 5)); }
__host__ __device__ __forceinline__ void stage_rc(int b, int& R, int& C) { const int st = b / 1024, sb = b % 1024, swz = sb ^ (((sb >> 9) & 1) << 5); R = (st >> 1) * 16 + swz / 64; C = (st & 1) * 32 + (swz % 64) / 2; }
__host__ __device__ __forceinline__ int perm32(int rho) { const int n = rho >> 4, i = rho & 15; return 8 * (i >> 2) + 4 * n + (i & 3); }

struct Unit { int pm, pn; };
struct Gemm { const bf16_t* A; const bf16_t* Bt; int M, N, K; };

struct StaticOrder {
    int nM, nN, nwg, G, c;
    __host__ __device__ void init(int M, int N, int G_, int c_) { nM = M / BM; nN = N / BM; nwg = nM * nN; G = G_; c = c_; }
    __host__ __device__ bool next(int i, Unit& u) const {
        const long L = (long)i * G + c; if (L >= nwg) return false;
        int wgid = (int)L; { const int q = nwg / NXCD, r = nwg % NXCD, xcd = wgid % NXCD, off = wgid / NXCD; wgid = (xcd < r ? xcd * (q + 1) : r * (q + 1) + (xcd - r) * q) + off; }
        const int nig = WGM * nN, gid = wgid / nig, fm = gid * WGM, gsz = (nM - fm) < WGM ? (nM - fm) : WGM;
        u.pm = fm + ((wgid % nig) % gsz); u.pn = (wgid % nig) / gsz; return true;
    }
    __device__ __forceinline__ void a_ready(const Unit&) const {}
    __device__ __forceinline__ void done(const Unit&) const {}
};

typedef float f32x2_t __attribute__((ext_vector_type(2))); typedef __bf16 bf16x2_t __attribute__((ext_vector_type(2)));
__device__ __forceinline__ unsigned cvt_pk_bf16(float lo, float hi) { f32x2_t v = {lo, hi}; bf16x2_t b = __builtin_convertvector(v, bf16x2_t); return __builtin_bit_cast(unsigned, b); }
template <int MODE> struct EpiGen {
    static constexpr bool PERM = true, AFTER_DRAIN = false;
    bf16_t* O; int ldc; const bf16_t* aux;
    __device__ __forceinline__ static float silu_f(float g) { return g * __builtin_amdgcn_rcpf(1.0f + __expf(-g)); }
    __device__ __forceinline__ static float sigm_f(float g) { return __builtin_amdgcn_rcpf(1.0f + __expf(-g)); }
    __device__ __forceinline__ void operator()(const f32x4 (&acc)[2][2][4][2], const Unit& u, int wr, int wc, int fr, int fq) const {
        const int row0 = u.pm * BM + wr * 64 + fr;
        if constexpr (MODE == 1) {
            const int col0 = u.pn * HALF + wc * 32 + 8 * fq;
#pragma unroll
            for (int ai = 0; ai < 2; ++ai)
#pragma unroll
                for (int m = 0; m < 4; ++m) { bf16_t* rowp = O + (size_t)(row0 + ai * HALF + m * 16) * ldc + col0;
                    const f32x4 g0 = acc[ai][0][m][0], g1 = acc[ai][0][m][1], u0 = acc[ai][1][m][0], u1 = acc[ai][1][m][1];
                    u32x4 w; w.x = cvt_pk_bf16(silu_f(g0[0]) * u0[0], silu_f(g0[1]) * u0[1]); w.y = cvt_pk_bf16(silu_f(g0[2]) * u0[2], silu_f(g0[3]) * u0[3]);
                    w.z = cvt_pk_bf16(silu_f(g1[0]) * u1[0], silu_f(g1[1]) * u1[1]); w.w = cvt_pk_bf16(silu_f(g1[2]) * u1[2], silu_f(g1[3]) * u1[3]);
                    *(u32x4*)rowp = w; }
        } else {
            const int col0 = u.pn * BM + wc * 32 + 8 * fq;
#pragma unroll
            for (int ai = 0; ai < 2; ++ai)
#pragma unroll
                for (int m = 0; m < 4; ++m) { const size_t off = (size_t)(row0 + ai * HALF + m * 16) * ldc + col0;
#pragma unroll
                    for (int bj = 0; bj < 2; ++bj) { f32x4 v0 = acc[ai][bj][m][0], v1 = acc[ai][bj][m][1];
                        if constexpr (MODE == 2) { v0 = (f32x4){sigm_f(v0[0]), sigm_f(v0[1]), sigm_f(v0[2]), sigm_f(v0[3])}; v1 = (f32x4){sigm_f(v1[0]), sigm_f(v1[1]), sigm_f(v1[2]), sigm_f(v1[3])}; }
                        if constexpr (MODE == 3) { const u32x4 a = *(const u32x4*)(aux + off + bj * HALF);
                            v0[0] *= __uint_as_float(a.x << 16); v0[1] *= __uint_as_float(a.x & 0xffff0000u); v0[2] *= __uint_as_float(a.y << 16); v0[3] *= __uint_as_float(a.y & 0xffff0000u);
                            v1[0] *= __uint_as_float(a.z << 16); v1[1] *= __uint_as_float(a.z & 0xffff0000u); v1[2] *= __uint_as_float(a.w << 16); v1[3] *= __uint_as_float(a.w & 0xffff0000u); }
                        u32x4 w; w.x = cvt_pk_bf16(v0[0], v0[1]); w.y = cvt_pk_bf16(v0[2], v0[3]); w.z = cvt_pk_bf16(v1[0], v1[1]); w.w = cvt_pk_bf16(v1[2], v1[3]);
                        *(u32x4*)(O + off + bj * HALF) = w; } }
        }
    }
};
template <class Epi, class Sched, bool ALIGN_EPI = false, bool SP2 = false>
__device__ __forceinline__ void gemm_phase(PG8_LAS unsigned char* lds, const Gemm g, const Sched& S, const Epi& E) {
    const int tid = threadIdx.x, wid = __builtin_amdgcn_readfirstlane(tid >> 6), lane = tid & 63, wr = wid >> 2, wc = wid & 3, fr = lane & 15, fq = lane >> 4;
    const int K = g.K, nt = K / BK;
    unsigned voffA[2], voffB[2];
#pragma unroll
    for (int i = 0; i < 2; ++i) { int R, C; stage_rc(tid * 16 + i * 8192, R, C); const int Rb = Epi::PERM ? ((R & ~31) + perm32(R & 31)) : R;
        voffA[i] = (unsigned)(R * K + C) * 2u; voffB[i] = (unsigned)(Rb * K + C) * 2u; }
    const size_t kstep = (size_t)(BK * 2);
    const size_t hstep = (size_t)HALF * K * 2;
    const size_t tstep = 2 * hstep;
    const unsigned ldsw = (unsigned)wid * 1024u;
    const int aoff = lds_byte(wr * 64 + fr, fq * 8), boff = lds_byte(wc * 32 + fr, fq * 8);
#define PG8_SA(b, h) (((b) * 2 + (h)) * HTB)
#define PG8_SB(b, h) ((4 + (b) * 2 + (h)) * HTB)
#define PG8_STAGE(bufoff, gbase, voff) do { _Pragma("unroll") for (int _i = 0; _i < 2; ++_i) \
        __builtin_amdgcn_global_load_lds((const unsigned*)((const char*)(gbase) + (voff)[_i]), (PG8_LAS unsigned*)(lds + (bufoff) + ldsw + _i * 8192), 16, 0, 0); } while (0)
#define PG8_LDA(dst, b, h) do { _Pragma("unroll") for (int m = 0; m < 4; ++m) _Pragma("unroll") for (int k = 0; k < 2; ++k) dst[m][k] = *(const PG8_LAS bf16x8*)(lds + PG8_SA(b, h) + aoff + m * 2048 + k * 1024); } while (0)
#define PG8_LDB(dst, b, h) do { _Pragma("unroll") for (int n = 0; n < 2; ++n) _Pragma("unroll") for (int k = 0; k < 2; ++k) dst[n][k] = *(const PG8_LAS bf16x8*)(lds + PG8_SB(b, h) + boff + n * 2048 + k * 1024); } while (0)
#define PG8_MMA(ai, bj, At, Bt) do { __builtin_amdgcn_s_setprio(1); _Pragma("unroll") for (int m = 0; m < 4; ++m) _Pragma("unroll") for (int n = 0; n < 2; ++n) _Pragma("unroll") for (int k = 0; k < 2; ++k) \
        acc[ai][bj][m][n] = __builtin_amdgcn_mfma_f32_16x16x32_bf16(Bt[n][k], At[m][k], acc[ai][bj][m][n], 0, 0, 0); __builtin_amdgcn_s_setprio(0); } while (0)
#define PG8_WAIT_V(n) asm volatile("s_waitcnt vmcnt(" #n ")" ::: "memory")
#define PG8_WAIT_L(n) asm volatile("s_waitcnt lgkmcnt(" #n ")" ::: "memory")
#define PG8_BAR __builtin_amdgcn_s_barrier()
#define PG8_SCHED __builtin_amdgcn_sched_barrier(0)
    Unit cur, nxt; int ui = 0;
    if (!S.next(0, cur)) return;
    f32x4 acc[2][2][4][2];
#pragma unroll
    for (int a = 0; a < 2; ++a)
#pragma unroll
        for (int b = 0; b < 2; ++b)
#pragma unroll
            for (int m = 0; m < 4; ++m)
#pragma unroll
                for (int n = 0; n < 2; ++n) acc[a][b][m][n] = (f32x4){0.f, 0.f, 0.f, 0.f};
    bf16x8 At[4][2], B0[2][2], B1[2][2];
    const char* cA = (const char*)g.A + (size_t)cur.pm * tstep; const char* cB = (const char*)g.Bt + (size_t)cur.pn * tstep;
    S.a_ready(cur);
    if constexpr (SP2) {
        PG8_STAGE(PG8_SB(0, 0), cB, voffB); PG8_STAGE(PG8_SB(0, 1), cB + hstep, voffB); PG8_STAGE(PG8_SA(0, 0), cA, voffA); PG8_STAGE(PG8_SA(0, 1), cA + hstep, voffA);
        if (wr == 1) PG8_BAR;
        PG8_WAIT_V(2); PG8_BAR;
        PG8_STAGE(PG8_SB(1, 0), cB + kstep, voffB); PG8_STAGE(PG8_SA(1, 0), cA + kstep, voffA); PG8_STAGE(PG8_SB(1, 1), cB + hstep + kstep, voffB);
        PG8_WAIT_V(6); PG8_BAR;
    } else {
        PG8_STAGE(PG8_SB(0, 0), cB, voffB); PG8_STAGE(PG8_SA(0, 0), cA, voffA); PG8_STAGE(PG8_SB(0, 1), cB + hstep, voffB); PG8_STAGE(PG8_SA(0, 1), cA + hstep, voffA);
        if (wr == 1) PG8_BAR;
        PG8_WAIT_V(4); PG8_BAR;
        PG8_STAGE(PG8_SB(1, 0), cB + kstep, voffB); PG8_STAGE(PG8_SA(1, 0), cA + kstep, voffA); PG8_STAGE(PG8_SB(1, 1), cB + hstep + kstep, voffB);
        PG8_WAIT_V(6); PG8_BAR;
    }
    for (;;) {
        const bool has_next = S.next(ui + 1, nxt);
        const char* nA = has_next ? (const char*)g.A + (size_t)nxt.pm * tstep : cA; const char* nB = has_next ? (const char*)g.Bt + (size_t)nxt.pn * tstep : cB;
        for (int t = 0; t < nt; t += 2) {
            const bool last = (t == nt - 2);
            const char* a1 = cA + (size_t)(t + 1) * kstep;
            const char* a2 = last ? nA : cA + (size_t)(t + 2) * kstep; const char* b2 = last ? nB : cB + (size_t)(t + 2) * kstep;
            const char* a3 = a2 + kstep; const char* b3 = b2 + kstep;
            if (last && has_next) S.a_ready(nxt);
            if constexpr (SP2) {
            PG8_LDB(B0, 0, 0); PG8_LDB(B1, 0, 1); PG8_SCHED; PG8_LDA(At, 0, 0); PG8_STAGE(PG8_SA(1, 1), a1 + hstep, voffA);
            PG8_WAIT_V(8); PG8_WAIT_L(0); PG8_BAR; PG8_MMA(0, 0, At, B0); PG8_MMA(0, 1, At, B1); PG8_BAR; PG8_SCHED;
            PG8_LDA(At, 0, 1); PG8_STAGE(PG8_SB(0, 0), b2, voffB); PG8_STAGE(PG8_SB(0, 1), b2 + hstep, voffB); PG8_STAGE(PG8_SA(0, 0), a2, voffA);
            PG8_WAIT_V(8); PG8_WAIT_L(0); PG8_BAR; PG8_MMA(1, 0, At, B0); PG8_MMA(1, 1, At, B1); PG8_BAR; PG8_SCHED;
            PG8_LDB(B0, 1, 0); PG8_LDB(B1, 1, 1); PG8_SCHED; PG8_LDA(At, 1, 0); PG8_STAGE(PG8_SA(0, 1), a2 + hstep, voffA);
            PG8_WAIT_V(8); PG8_WAIT_L(0); PG8_BAR; PG8_MMA(0, 0, At, B0); PG8_MMA(0, 1, At, B1); PG8_BAR; PG8_SCHED;
            PG8_LDA(At, 1, 1); PG8_STAGE(PG8_SB(1, 0), b3, voffB); PG8_STAGE(PG8_SB(1, 1), b3 + hstep, voffB); PG8_STAGE(PG8_SA(1, 0), a3, voffA);
            PG8_WAIT_V(8); PG8_WAIT_L(0); PG8_BAR; PG8_MMA(1, 0, At, B0); PG8_MMA(1, 1, At, B1); PG8_BAR; PG8_SCHED;
            } else {
            PG8_LDB(B0, 0, 0); PG8_SCHED; PG8_LDA(At, 0, 0); PG8_STAGE(PG8_SA(1, 1), a1 + hstep, voffA);
            PG8_WAIT_L(8); PG8_BAR; PG8_WAIT_L(0); PG8_MMA(0, 0, At, B0); PG8_BAR; PG8_SCHED;
            PG8_LDB(B1, 0, 1); PG8_STAGE(PG8_SB(0, 0), b2, voffB);
            PG8_BAR; PG8_WAIT_L(0); PG8_MMA(0, 1, At, B1); PG8_BAR;
            PG8_LDA(At, 0, 1); PG8_STAGE(PG8_SA(0, 0), a2, voffA);
            PG8_BAR; PG8_WAIT_L(0); PG8_MMA(1, 0, At, B0); PG8_BAR; PG8_SCHED;
            PG8_STAGE(PG8_SB(0, 1), b2 + hstep, voffB);
            PG8_WAIT_V(6); PG8_BAR; PG8_MMA(1, 1, At, B1); PG8_BAR;
            PG8_LDB(B0, 1, 0); PG8_SCHED; PG8_LDA(At, 1, 0); PG8_STAGE(PG8_SA(0, 1), a2 + hstep, voffA);
            PG8_WAIT_L(8); PG8_BAR; PG8_WAIT_L(0); PG8_MMA(0, 0, At, B0); PG8_BAR; PG8_SCHED;
            PG8_LDB(B1, 1, 1); PG8_STAGE(PG8_SB(1, 0), b3, voffB);
            PG8_BAR; PG8_WAIT_L(0); PG8_MMA(0, 1, At, B1); PG8_BAR;
            PG8_LDA(At, 1, 1); PG8_STAGE(PG8_SA(1, 0), a3, voffA);
            PG8_BAR; PG8_WAIT_L(0); PG8_MMA(1, 0, At, B0); PG8_BAR; PG8_SCHED;
            PG8_STAGE(PG8_SB(1, 1), b3 + hstep, voffB);
            PG8_WAIT_V(6); PG8_BAR; PG8_MMA(1, 1, At, B1); PG8_BAR;
            }
        }
        if constexpr (ALIGN_EPI) { if (wr == 0) PG8_BAR; }
        if constexpr (!Epi::AFTER_DRAIN) { E(acc, cur, wr, wc, fr, fq); S.done(cur); }
        if (!has_next) break;
#pragma unroll
        for (int a = 0; a < 2; ++a)
#pragma unroll
            for (int b = 0; b < 2; ++b)
#pragma unroll
                for (int m = 0; m < 4; ++m)
#pragma unroll
                    for (int n = 0; n < 2; ++n) acc[a][b][m][n] = (f32x4){0.f, 0.f, 0.f, 0.f};
        cur = nxt; cA = nA; cB = nB; ++ui;
        if constexpr (ALIGN_EPI) { if (wr == 1) PG8_BAR; }
    }
    PG8_WAIT_V(0);
    if constexpr (!ALIGN_EPI) { if (wr == 0) PG8_BAR; }
    PG8_BAR;
    if constexpr (Epi::AFTER_DRAIN) { E.fused(acc, cur, wr, wc, fr, fq, lds, wid, lane); S.done(cur); }
#undef PG8_SA
#undef PG8_SB
#undef PG8_STAGE
#undef PG8_LDA
#undef PG8_LDB
#undef PG8_MMA
#undef PG8_WAIT_V
#undef PG8_WAIT_L
#undef PG8_BAR
#undef PG8_SCHED
}
}

#ifndef PG8_SP2
#define PG8_SP2 true
#endif
#ifndef PG8_ALIGN
#define PG8_ALIGN true
#endif
constexpr int NWAVES = 8;
#ifndef MK_N_LAUNCHES
#define MK_N_LAUNCHES 1
#endif
constexpr int N_PHASES = 16;
constexpr int D = 1024, SEQ = 8192, NB = 2, MP = NB * SEQ, DECB = 128, DECT = 4, MS = DECB * DECT, M = MP + MS;
constexpr int FF = 2816, PLE = 256, NIN = 2824, LDC = 3072;
constexpr int C_Q = 0, C_K = 512, C_V = 1024, C_Z = 1536, C_QS = 2048, C_KS = 2560, C_VS = 2688, C_B = 2816, C_A = 2820;
constexpr float EPS = 1e-6f;
constexpr size_t O_Y = 0, O_CONVP = (size_t)M * D, O_GDNP = O_CONVP + 2 * 3 * 1536, O_KP = O_GDNP + 2 * 4 * 128 * 128, O_VP = O_KP + 2 * 128 * 2 * 64,
                 O_CONVS = O_VP + 2 * 128 * 2 * 64, O_GDNS = O_CONVS + (size_t)128 * 3 * 1536, O_KS = O_GDNS + (size_t)128 * 4 * 128 * 128, O_VS = O_KS + (size_t)128 * 128 * 2 * 64,
                 O_END = O_VS + (size_t)128 * 128 * 2 * 64;
constexpr size_t MiB = 1u << 20, KiB = 1024;
constexpr size_t WS_CTL = 0, CTL_ZERO_BYTES = 1 * MiB;
constexpr size_t WS_WGU1 = 1 * MiB, WS_WD1 = 12 * MiB, WS_WIN = 17 * MiB + 512 * KiB, WS_WOUT = 23 * MiB + 512 * KiB, WS_WGU2 = 25 * MiB + 512 * KiB, WS_WD2 = 36 * MiB + 512 * KiB,
                 WS_WPG = 42 * MiB, WS_WPP = 44 * MiB, WS_PBUF = 45 * MiB, WS_HBUF = 54 * MiB, WS_BIG = 87 * MiB, WS_TMP = 186 * MiB, WS_MIXIN = 219 * MiB, WS_END = 252 * MiB;
static_assert(WS_WGU1 + (size_t)2 * FF * D * 2 <= WS_WD1 && WS_WD1 + (size_t)D * FF * 2 <= WS_WIN && WS_WIN + (size_t)LDC * D * 2 <= WS_WOUT && WS_WOUT + (size_t)D * D * 2 <= WS_WGU2 &&
              WS_WGU2 + (size_t)2 * FF * D * 2 <= WS_WD2 && WS_WD2 + (size_t)D * FF * 2 <= WS_WPG && WS_WPG + (size_t)D * D * 2 <= WS_WPP && WS_WPP + (size_t)D * PLE * 2 <= WS_PBUF &&
              WS_PBUF + (size_t)M * PLE * 2 <= WS_HBUF && WS_HBUF + (size_t)M * D * 2 <= WS_BIG && WS_BIG + (size_t)M * LDC * 2 <= WS_TMP && WS_TMP + (size_t)M * D * 2 <= WS_MIXIN &&
              WS_MIXIN + (size_t)M * D * 2 <= WS_END, "d_ws map");
constexpr int CW_TMO = 0, CW_CODE = 1, CW_BAR = 4096;
constexpr int RING_OFF = 0, RING_BYTES = 131072, LDSCTL_OFF = RING_BYTES, MISC_OFF = LDSCTL_OFF + 320, LDS_BYTES = 147456;

#define GAS __attribute__((address_space(1)))
#define LAS __attribute__((address_space(3)))
typedef unsigned short bf16;
typedef unsigned v4u __attribute__((ext_vector_type(4)));
typedef unsigned v2u __attribute__((ext_vector_type(2)));
typedef float f32x4 __attribute__((ext_vector_type(4)));
typedef GAS unsigned gu32;
#define RLX_AGENT __ATOMIC_RELAXED, __HIP_MEMORY_SCOPE_AGENT
#define LDS_WAIT() asm volatile("s_waitcnt lgkmcnt(0)" ::: "memory")
#define VM_WAIT() asm volatile("s_waitcnt vmcnt(0)" ::: "memory")
__device__ __forceinline__ unsigned f2bf(float f) { unsigned u = __builtin_bit_cast(unsigned, f); return (u + 0x7fffu + ((u >> 16) & 1u)) >> 16; }
__device__ __forceinline__ unsigned pk2(float lo, float hi) { return f2bf(lo) | (f2bf(hi) << 16); }
__device__ __forceinline__ float bf2f(bf16 u) { return __uint_as_float((unsigned)u << 16); }
__device__ __forceinline__ float bflo(unsigned u) { return __uint_as_float(u << 16); }
__device__ __forceinline__ float bfhi(unsigned u) { return __uint_as_float(u & 0xffff0000u); }
#define XB_TMO      128
#define XB_XCNT(j)  (256  + 64 * (j))
#define XB_XSUB(j)  (1280 + 64 * (j))
#define XB_XGEN(j)  (2304 + 64 * (j))
#define XB_TOP      3328
#define XB_TOPGEN   3392
#define XCD_BAR_WORDS 3456
#define XB_SPIN_CAP (1u << 27)

__device__ __forceinline__ unsigned xb_ld(unsigned* p)              { return __hip_atomic_load(p, __ATOMIC_RELAXED, __HIP_MEMORY_SCOPE_AGENT); }
__device__ __forceinline__ unsigned xb_add(unsigned* p, unsigned v) { return __hip_atomic_fetch_add(p, v, __ATOMIC_RELAXED, __HIP_MEMORY_SCOPE_AGENT); }
__device__ __forceinline__ unsigned xb_xcc_id() { return (unsigned)__builtin_amdgcn_s_getreg((3 << 11) | 20) & 0xFu; }
#define XB_SPIN(cond, bar) do { unsigned _sp = 0; while (cond) { __builtin_amdgcn_s_sleep(1); \
    if ((++_sp & 255u) == 0u) { if (xb_ld(&(bar)[XB_TMO])) break; if (_sp > XB_SPIN_CAP) { atomicAdd(&(bar)[XB_TMO], 1u); break; } } } } while (0)

struct XcdBarrier {
    unsigned* bar; unsigned x;
    volatile LAS unsigned* st;
};

__device__ __forceinline__ XcdBarrier xcd_barrier_post(unsigned* bar, volatile LAS unsigned* st) {
    XcdBarrier b; b.bar = bar; b.x = xb_xcc_id(); b.st = st;
    if (threadIdx.x == 0) (void)xb_add(&bar[XB_XCNT(b.x)], 1u);
    return b;
}
__device__ __forceinline__ void xcd_barrier_complete(unsigned* bar, unsigned x, unsigned& nloc, unsigned& nx) {
    const unsigned G = gridDim.x * gridDim.y * gridDim.z;
    unsigned sum, cnt, mine, sp = 0u;
    for (;;) {
        sum = 0u; cnt = 0u; mine = 0u;
#pragma unroll
        for (unsigned j = 0; j < 16; ++j) { const unsigned c = xb_ld(&bar[XB_XCNT(j)]); sum += c; cnt += (c > 0u) ? 1u : 0u; mine = (j == x) ? c : mine; }
        if (sum == G) break;
        __builtin_amdgcn_s_sleep(1);
        if ((++sp & 255u) == 0u) { if (xb_ld(&bar[XB_TMO])) break; if (sp > XB_SPIN_CAP) { atomicAdd(&bar[XB_TMO], 1u); break; } }
    }
    nloc = mine > 0u ? mine : 1u; nx = cnt > 0u ? cnt : 1u;
}

__device__ __forceinline__ void xcd_barrier(const XcdBarrier& b) {
    asm volatile("s_waitcnt vmcnt(0)" ::: "memory");
    __syncthreads();
    if (threadIdx.x == 0) {
        unsigned* bar = b.bar;
        __builtin_amdgcn_s_waitcnt(0);
        unsigned nloc = b.st[0], nx = b.st[1];
        if (nloc == 0u) { xcd_barrier_complete(bar, b.x, nloc, nx); b.st[0] = nloc; b.st[1] = nx; }
        const unsigned old = xb_add(&bar[XB_XSUB(b.x)], 1u);
        const unsigned gen = old / nloc;
        if (old + 1u == (gen + 1u) * nloc) {
            __builtin_amdgcn_fence(__ATOMIC_RELEASE, "agent");
            asm volatile("s_waitcnt vmcnt(0)" ::: "memory");
            const unsigned og = xb_add(&bar[XB_TOP], 1u);
            const unsigned tg = og / nx;
            if (og + 1u == (tg + 1u) * nx) xb_add(&bar[XB_TOPGEN], 1u);
            else XB_SPIN(xb_ld(&bar[XB_TOPGEN]) == tg, bar);
            __builtin_amdgcn_fence(__ATOMIC_ACQUIRE, "agent");
            xb_add(&bar[XB_XGEN(b.x)], 1u);
            asm volatile("s_waitcnt vmcnt(0)" ::: "memory");
        } else {
            XB_SPIN(xb_ld(&bar[XB_XGEN(b.x)]) == gen, bar);
            __builtin_amdgcn_fence(__ATOMIC_ACQUIRE, "agent");
            asm volatile("s_waitcnt vmcnt(0)" ::: "memory");
        }
    }
    __syncthreads();
}
struct Args { const float* in[31]; float* out; unsigned char* ws; int ph_lo, ph_hi; };
struct Frame {
    LAS unsigned char* lds;
    volatile LAS unsigned* MISC;
    gu32* ctl;
    int tid, lane, wave;
    int vcu, G;
    float* out; unsigned char* ws;
};
__device__ __forceinline__ float wave_sum(float v) {
#pragma unroll
    for (int o = 1; o < 64; o <<= 1) v += __shfl_xor(v, o);
    return v;
}
__device__ __forceinline__ float wave_max(float v) {
#pragma unroll
    for (int o = 1; o < 64; o <<= 1) v = fmaxf(v, __shfl_xor(v, o));
    return v;
}
__device__ __forceinline__ float silu_f(float g) { return g / (1.0f + __expf(-g)); }
__device__ __forceinline__ float sigm_f(float g) { return 1.0f / (1.0f + __expf(-g)); }
__device__ __forceinline__ const float* xin_row(const float* xp, const float* xs, int m) { return m < MP ? xp + (size_t)m * D : xs + (size_t)(m - MP) * D; }

__device__ __forceinline__ void tr_item(const float* W, int ldw, int n0, int nvalid, int k0, bf16* WT, int ldk, int drow0, LAS float* scr, int lane) {
    const int c = lane & 31;
#pragma unroll 8
    for (int i = 0; i < 32; ++i) { const int kk = 2 * i + (lane >> 5); scr[kk * 33 + c] = (c < nvalid) ? W[(size_t)(k0 + kk) * ldw + n0 + c] : 0.f; }
    LDS_WAIT(); asm volatile("" ::: "memory");
    const int c8 = lane & 7;
#pragma unroll
    for (int j = 0; j < 4; ++j) { const int n = (lane >> 3) + 8 * j; const LAS float* s = scr + (8 * c8) * 33 + n;
        v4u o; o.x = pk2(s[0 * 33], s[1 * 33]); o.y = pk2(s[2 * 33], s[3 * 33]); o.z = pk2(s[4 * 33], s[5 * 33]); o.w = pk2(s[6 * 33], s[7 * 33]);
        if (n < nvalid) *(GAS v4u*)(WT + (size_t)(drow0 + n) * ldk + k0 + 8 * c8) = o; }
    LDS_WAIT(); asm volatile("" ::: "memory");
}
__device__ __forceinline__ void tr_plain(const float* W, int K, int N, bf16* WT, int item, LAS float* scr, int lane) {
    const int nblk = N / 32, kb = item / nblk, nb = item % nblk;
    tr_item(W, N, 32 * nb, 32, 64 * kb, WT, K, 32 * nb, scr, lane);
}
__device__ __forceinline__ void tr_gu(const float* W, bf16* WT, int up, int item, LAS float* scr, int lane) {
    const int nblk = FF / 32, kb = item / nblk, nb = item % nblk, c0 = 32 * nb;
    tr_item(W, FF, c0, 32, 64 * kb, WT, D, 256 * (c0 >> 7) + (c0 & 127) + up * 128, scr, lane);
}
__device__ __forceinline__ void tr_win(const float* W, bf16* WT, int item, LAS float* scr, int lane) {
    const int nblk = 89, kb = item / nblk, nb = item % nblk;
    int n0, nv, d0;
    if (nb < 64) { n0 = 32 * nb; nv = 32; d0 = n0; } else if (nb == 64) { n0 = 2048; nv = 8; d0 = 2816; } else { n0 = 2056 + 32 * (nb - 65); nv = 32; d0 = 2048 + 32 * (nb - 65); }
    tr_item(W, NIN, n0, nv, 64 * kb, WT, D, d0, scr, lane);
}
__device__ __forceinline__ void rms_row_to_bf16(const float* xrow, const float* gain, bf16* orow, int lane) {
    const GAS f32x4* xr = (const GAS f32x4*)xrow + lane; const GAS f32x4* gr = (const GAS f32x4*)gain + lane;
    f32x4 v[4]; float s = 0.f;
#pragma unroll
    for (int j = 0; j < 4; ++j) { v[j] = xr[64 * j]; s += (v[j].x * v[j].x + v[j].y * v[j].y) + (v[j].z * v[j].z + v[j].w * v[j].w); }
    const float r = 1.0f / sqrtf(wave_sum(s) * (1.f / D) + EPS);
    GAS v2u* o8 = (GAS v2u*)orow + lane;
#pragma unroll
    for (int j = 0; j < 4; ++j) { const f32x4 g = gr[64 * j]; v2u o; o.x = pk2(v[j].x * r * g.x, v[j].y * r * g.y); o.y = pk2(v[j].z * r * g.z, v[j].w * r * g.w); o8[64 * j] = o; }
}
__device__ __forceinline__ void p0_prologue(Frame& F, const Args& A) {
    LAS float* scr = (LAS float*)(F.lds + RING_OFF + F.wave * 16384);
    const int gw = F.vcu * NWAVES + F.wave, NGW = F.G * NWAVES;
    bf16* WGU1 = (bf16*)(F.ws + WS_WGU1); bf16* WD1 = (bf16*)(F.ws + WS_WD1); bf16* WIN = (bf16*)(F.ws + WS_WIN); bf16* WOUT = (bf16*)(F.ws + WS_WOUT);
    bf16* WGU2 = (bf16*)(F.ws + WS_WGU2); bf16* WD2 = (bf16*)(F.ws + WS_WD2); bf16* WPG = (bf16*)(F.ws + WS_WPG); bf16* WPP = (bf16*)(F.ws + WS_WPP);
    constexpr int I_GU = (D / 64) * (FF / 32), I_DN = (FF / 64) * (D / 32), I_IN = (D / 64) * 89, I_SQ = (D / 64) * (D / 32), I_PP = (PLE / 64) * (D / 32);
    constexpr int NITEMS = 4 * I_GU + 2 * I_DN + I_IN + 2 * I_SQ + I_PP;
    for (int it = gw; it < NITEMS; it += NGW) {
        int r = it;
        if (r < I_GU) { tr_gu(A.in[11], WGU1, 0, r, scr, F.lane); continue; } r -= I_GU;
        if (r < I_GU) { tr_gu(A.in[12], WGU1, 1, r, scr, F.lane); continue; } r -= I_GU;
        if (r < I_DN) { tr_plain(A.in[13], FF, D, WD1, r, scr, F.lane); continue; } r -= I_DN;
        if (r < I_IN) { tr_win(A.in[16], WIN, r, scr, F.lane); continue; } r -= I_IN;
        if (r < I_SQ) { tr_plain(A.in[22], D, D, WOUT, r, scr, F.lane); continue; } r -= I_SQ;
        if (r < I_GU) { tr_gu(A.in[25], WGU2, 0, r, scr, F.lane); continue; } r -= I_GU;
        if (r < I_GU) { tr_gu(A.in[26], WGU2, 1, r, scr, F.lane); continue; } r -= I_GU;
        if (r < I_DN) { tr_plain(A.in[27], FF, D, WD2, r, scr, F.lane); continue; } r -= I_DN;
        if (r < I_SQ) { tr_plain(A.in[28], D, D, WPG, r, scr, F.lane); continue; } r -= I_SQ;
        tr_plain(A.in[29], PLE, D, WPP, r, scr, F.lane);
    }
    for (int rr = gw; rr < LDC - NIN; rr += NGW) { GAS v4u* o = (GAS v4u*)(WIN + (size_t)(NIN + rr) * D) + F.lane; o[0] = (v4u){0, 0, 0, 0}; o[64] = (v4u){0, 0, 0, 0}; }
    bf16* HB = (bf16*)(F.ws + WS_HBUF); bf16* PB = (bf16*)(F.ws + WS_PBUF);
    for (int m = gw; m < M; m += NGW) {
        rms_row_to_bf16(xin_row(A.in[0], A.in[1], m), A.in[9], HB + (size_t)m * D, F.lane);
        const float* prow = m < MP ? A.in[6] + (size_t)m * PLE : A.in[7] + (size_t)(m - MP) * PLE;
        const f32x4 pv = ((const GAS f32x4*)prow)[F.lane]; v2u o; o.x = pk2(pv.x, pv.y); o.y = pk2(pv.z, pv.w); ((GAS v2u*)(PB + (size_t)m * PLE))[F.lane] = o;
    }
}
template <int HMODE, bool BASE_IN>
__device__ __forceinline__ void resid_pass(Frame& F, const float* xp, const float* xs, const bf16* src, float scale, const float* gpost, const float* g2, bf16* hout) {
    const int gw = F.vcu * NWAVES + F.wave, NGW = F.G * NWAVES;
    for (int m = gw; m < M; m += NGW) {
        const GAS v2u* sr = (const GAS v2u*)(src + (size_t)m * D) + F.lane;
        const float* brow = BASE_IN ? xin_row(xp, xs, m) : F.out + (size_t)m * D;
        const GAS f32x4* br = (const GAS f32x4*)brow + F.lane; const GAS f32x4* gp = (const GAS f32x4*)gpost + F.lane;
        f32x4 v[4], b[4]; float s = 0.f;
#pragma unroll
        for (int j = 0; j < 4; ++j) { const v2u w = sr[64 * j]; v[j] = (f32x4){bflo(w.x), bfhi(w.x), bflo(w.y), bfhi(w.y)}; b[j] = br[64 * j];
            s += (v[j].x * v[j].x + v[j].y * v[j].y) + (v[j].z * v[j].z + v[j].w * v[j].w); }
        const float r = scale / sqrtf(wave_sum(s) * (1.f / D) + EPS);
        float s2 = 0.f;
        GAS f32x4* orow = (GAS f32x4*)(F.out + (size_t)m * D) + F.lane;
#pragma unroll
        for (int j = 0; j < 4; ++j) { const f32x4 g = gp[64 * j]; v[j] = b[j] + v[j] * r * g; orow[64 * j] = v[j];
            s2 += (v[j].x * v[j].x + v[j].y * v[j].y) + (v[j].z * v[j].z + v[j].w * v[j].w); }
        if constexpr (HMODE == 1) {
            const float r2 = 1.0f / sqrtf(wave_sum(s2) * (1.f / D) + EPS); const GAS f32x4* g2r = (const GAS f32x4*)g2 + F.lane; GAS v2u* o8 = (GAS v2u*)(hout + (size_t)m * D) + F.lane;
#pragma unroll
            for (int j = 0; j < 4; ++j) { const f32x4 g = g2r[64 * j]; v2u o; o.x = pk2(v[j].x * r2 * g.x, v[j].y * r2 * g.y); o.y = pk2(v[j].z * r2 * g.z, v[j].w * r2 * g.w); o8[64 * j] = o; }
        } else if constexpr (HMODE == 2) {
            GAS v2u* o8 = (GAS v2u*)(hout + (size_t)m * D) + F.lane;
#pragma unroll
            for (int j = 0; j < 4; ++j) { v2u o; o.x = pk2(v[j].x, v[j].y); o.y = pk2(v[j].z, v[j].w); o8[64 * j] = o; }
        }
    }
}
__device__ __forceinline__ int t5_bucket(int d) {
    if (d < 16) return d;
    return 16 + (d >= 19) + (d >= 21) + (d >= 24) + (d >= 27) + (d >= 31) + (d >= 35) + (d >= 40) + (d >= 46) + (d >= 52) + (d >= 59) + (d >= 67) + (d >= 77) + (d >= 87) + (d >= 99) + (d >= 113);
}
__device__ __forceinline__ float softplus_f(float x) { return x > 20.f ? x : log1pf(__expf(x)); }

__device__ __forceinline__ void gdn_naive_item(Frame& F, const Args& A, bool prompt, int sidx, int h) {
    const bf16* cols = (const bf16*)(F.ws + WS_BIG); bf16* mix = (bf16*)(F.ws + WS_MIXIN);
    LAS float* ybuf = (LAS float*)(F.lds + RING_OFF);
    LAS float* red = ybuf + 384;
    LAS float* pa = ybuf + 512;
    LAS float* pb = pa + 512;
    LAS float* red2 = pb + 512;
    const int tid = F.tid, part = tid >> 7, dv = tid & 127, lane = F.lane, wave = F.wave;
    const int T = prompt ? SEQ : DECT, row0 = prompt ? sidx * SEQ : MP + sidx * DECT;
    float S[32];
    if (prompt) {
#pragma unroll
        for (int i = 0; i < 32; ++i) S[i] = 0.f;
    } else {
        const float* s0 = A.in[3] + ((size_t)(sidx * 4 + h) * 128 + part * 32) * 128 + dv;
#pragma unroll
        for (int i = 0; i < 32; ++i) S[i] = s0[(size_t)i * 128];
    }
    const int ch = tid, kind = ch >> 7, col = kind * 512 + h * 128 + (ch & 127);
    float w0 = 0.f, w1 = 0.f, w2 = 0.f, w3 = 0.f, r0 = 0.f, r1 = 0.f, r2 = 0.f;
    if (tid < 384) { const float* cw = A.in[17]; w0 = cw[col]; w1 = cw[1536 + col]; w2 = cw[2 * 1536 + col]; w3 = cw[3 * 1536 + col];
        if (!prompt) { const float* sc = A.in[2] + (size_t)sidx * 3 * 1536; r0 = sc[col]; r1 = sc[1536 + col]; r2 = sc[2 * 1536 + col]; } }
    const float Aneg = -__expf(A.in[18][h]), dtb = A.in[19][h], gain = A.in[20][dv];
    for (int t = 0; t < T; ++t) {
        const bf16* crow = cols + (size_t)(row0 + t) * LDC;
        if (tid < 384) {
            const float x = bf2f(crow[col]); float y = r0 * w0 + r1 * w1 + r2 * w2 + x * w3; r0 = r1; r1 = r2; r2 = x;
            y = silu_f(y); ybuf[ch] = y; const float sq = wave_sum(y * y); if (lane == 0) red[wave] = sq;
        }
        __syncthreads();
        const float rq = 0.08838834764831845f / sqrtf(red[0] + red[1] + 1e-6f), rk = 1.0f / sqrtf(red[2] + red[3] + 1e-6f);
        const float bb = bf2f(crow[C_B + h]), aa = bf2f(crow[C_A + h]);
        const float beta = sigm_f(bb), g = Aneg * softplus_f(aa + dtb), a = __expf(g);
        float ks = 0.f;
#pragma unroll
        for (int i = 0; i < 32; ++i) ks += ybuf[128 + part * 32 + i] * S[i];
        pa[part * 128 + dv] = ks;
        __syncthreads();
        const float kst = ((pa[dv] + pa[128 + dv]) + (pa[256 + dv] + pa[384 + dv])) * rk;
        const float vnew = beta * (ybuf[256 + dv] - a * kst);
        float op = 0.f;
#pragma unroll
        for (int i = 0; i < 32; ++i) { const float kk = ybuf[128 + part * 32 + i] * rk; S[i] = a * S[i] + kk * vnew; op += ybuf[part * 32 + i] * S[i]; }
        pb[part * 128 + dv] = op * rq;
        __syncthreads();
        const float o = (pb[dv] + pb[128 + dv]) + (pb[256 + dv] + pb[384 + dv]);
        if (tid < 128) { const float sq = wave_sum(o * o); if (lane == 0) red2[wave] = sq; }
        __syncthreads();
        if (tid < 128) { const float rn = 1.0f / sqrtf((red2[0] + red2[1]) * (1.f / 128.f) + EPS); const float zz = bf2f(crow[C_Z + h * 128 + dv]);
            mix[(size_t)(row0 + t) * D + h * 128 + dv] = (bf16)f2bf(o * rn * gain * silu_f(zz)); }
    }
    float* so = F.out + (prompt ? O_GDNP : O_GDNS) + ((size_t)(sidx * 4 + h) * 128 + part * 32) * 128 + dv;
#pragma unroll
    for (int i = 0; i < 32; ++i) so[(size_t)i * 128] = S[i];
    __syncthreads();
}

__device__ __forceinline__ void swa_scores(Frame& F, const Args& A, const bf16* cols, bool prompt, int b, int t, int s, int qi, int kh, int hf, LAS float* qs, float (&sc)[4]) {
    const int w = F.lane + 64 * hf, dist = 127 - w;
    bool valid = true; const bf16* kb = cols; const float* kf = nullptr;
    if (prompt) { const int pos = t - dist; valid = pos >= 0; kb = cols + (size_t)(b * SEQ + (valid ? pos : 0)) * LDC + C_KS + kh * 64; }
    else { const int j = qi + 1 + w; if (j < 128) kf = A.in[4] + ((size_t)(s * 128 + j) * 2 + kh) * 64; else kb = cols + (size_t)(MP + s * DECT + (j - 128)) * LDC + C_KS + kh * 64; }
    float a0 = 0.f, a1 = 0.f, a2 = 0.f, a3 = 0.f;
#pragma unroll 1
    for (int d4 = 0; d4 < 16; ++d4) {
        float k0, k1, k2, k3;
        if (kf) { const f32x4 x0 = ((const GAS f32x4*)kf)[d4]; k0 = x0.x; k1 = x0.y; k2 = x0.z; k3 = x0.w; }
        else { const v2u x = ((const GAS v2u*)kb)[d4]; k0 = bflo(x.x); k1 = bfhi(x.x); k2 = bflo(x.y); k3 = bfhi(x.y); }
        const LAS f32x4* q4 = (const LAS f32x4*)qs + d4;
        const f32x4 q0 = q4[0], q1 = q4[16], q2 = q4[32], q3 = q4[48];
        a0 += q0.x * k0 + q0.y * k1 + q0.z * k2 + q0.w * k3; a1 += q1.x * k0 + q1.y * k1 + q1.z * k2 + q1.w * k3;
        a2 += q2.x * k0 + q2.y * k1 + q2.z * k2 + q2.w * k3; a3 += q3.x * k0 + q3.y * k1 + q3.z * k2 + q3.w * k3;
    }
    const int bk = t5_bucket(dist); const float* rb = A.in[8] + bk * 8 + kh * 4;
    sc[0] = valid ? a0 + rb[0] : -INFINITY; sc[1] = valid ? a1 + rb[1] : -INFINITY; sc[2] = valid ? a2 + rb[2] : -INFINITY; sc[3] = valid ? a3 + rb[3] : -INFINITY;
}
__device__ __forceinline__ void swa_item(Frame& F, const Args& A, int m, int kh, LAS float* qs, LAS float* ps) {
    const bf16* cols = (const bf16*)(F.ws + WS_BIG); bf16* mix = (bf16*)(F.ws + WS_MIXIN);
    const int lane = F.lane; const bool prompt = m < MP;
    const int b = prompt ? m / SEQ : 0, t = prompt ? m % SEQ : 0, s = prompt ? 0 : (m - MP) / DECT, qi = prompt ? 0 : (m - MP) % DECT;
    const bf16* qrow = cols + (size_t)m * LDC + C_QS + kh * 256;
#pragma unroll
    for (int g = 0; g < 4; ++g) qs[g * 64 + lane] = bf2f(qrow[g * 64 + lane]) * 0.125f;
    LDS_WAIT(); asm volatile("" ::: "memory");
    float sc[2][4];
    swa_scores(F, A, cols, prompt, b, t, s, qi, kh, 0, qs, sc[0]);
    swa_scores(F, A, cols, prompt, b, t, s, qi, kh, 1, qs, sc[1]);
#pragma unroll
    for (int g = 0; g < 4; ++g) {
        const float sink = A.in[21][kh * 4 + g];
        const float mx = fmaxf(wave_max(fmaxf(sc[0][g], sc[1][g])), sink);
        const float e0 = __expf(sc[0][g] - mx), e1 = __expf(sc[1][g] - mx);
        const float den = wave_sum(e0 + e1) + __expf(sink - mx), inv = 1.0f / den;
        ps[g * 128 + lane] = e0 * inv; ps[g * 128 + 64 + lane] = e1 * inv;
    }
    LDS_WAIT(); asm volatile("" ::: "memory");
    float o0 = 0.f, o1 = 0.f, o2 = 0.f, o3 = 0.f;
    const int wlo = prompt ? (t >= 127 ? 0 : 127 - t) : 0;
#pragma unroll 2
    for (int w = wlo; w < 128; ++w) {
        float v;
        if (prompt) v = bf2f(cols[(size_t)(b * SEQ + t - 127 + w) * LDC + C_VS + kh * 64 + lane]);
        else { const int j = qi + 1 + w; v = j < 128 ? A.in[5][((size_t)(s * 128 + j) * 2 + kh) * 64 + lane] : bf2f(cols[(size_t)(MP + s * DECT + (j - 128)) * LDC + C_VS + kh * 64 + lane]); }
        o0 += ps[w] * v; o1 += ps[128 + w] * v; o2 += ps[256 + w] * v; o3 += ps[384 + w] * v;
    }
    bf16* orow = mix + (size_t)m * D + 512 + kh * 256;
    orow[lane] = (bf16)f2bf(o0); orow[64 + lane] = (bf16)f2bf(o1); orow[128 + lane] = (bf16)f2bf(o2); orow[192 + lane] = (bf16)f2bf(o3);
    LDS_WAIT(); asm volatile("" ::: "memory");
}

constexpr size_t WS_G1 = WS_HBUF, WS_G2 = WS_TMP, WS_UF = WS_WGU1, WS_GCD = WS_END;
constexpr int CDTAB_OFF = LDSCTL_OFF + 1024;
constexpr int NCH = 128;
typedef short bf16x8 __attribute__((ext_vector_type(8)));
__device__ __forceinline__ unsigned cvtpk(float lo, float hi) { return pg8::cvt_pk_bf16(lo, hi); }

__device__ __forceinline__ void gdn_prep_item(Frame& F, const Args& A, int b, int n, int h) {
    const bf16* cols = (const bf16*)(F.ws + WS_BIG);
    const int ch = (b * NCH + n) * 4 + h, tid = F.tid, lane = F.lane, wave = F.wave;
    bf16* G1 = (bf16*)(F.ws + WS_G1) + (size_t)ch * 16384; bf16* G2 = (bf16*)(F.ws + WS_G2) + (size_t)ch * 12288;
    bf16* UF = (bf16*)(F.ws + WS_UF) + (size_t)ch * 8192; float* CD = (float*)(F.ws + WS_GCD);
    LAS float* Lm = (LAS float*)(F.lds + 0);
    LAS float* SC = (LAS float*)(F.lds + 17408);
    LAS bf16* Kb = (LAS bf16*)(F.lds + 18432);
    LAS bf16* Qb = (LAS bf16*)(F.lds + 35840);
    LAS float* RHS = (LAS float*)(F.lds + 53248);
    const int r0 = b * SEQ + n * 64;
    if (wave == 0) {
        const bf16* crow = cols + (size_t)(r0 + lane) * LDC;
        const float bb = bf2f(crow[C_B + h]), aa = bf2f(crow[C_A + h]);
        const float beta = sigm_f(bb), g = -__expf(A.in[18][h]) * softplus_f(aa + A.in[19][h]);
        float gc = g;
#pragma unroll
        for (int o = 1; o < 64; o <<= 1) { const float t = __shfl_up(gc, o); if (lane >= o) gc += t; }
        const float gl = __shfl(gc, 63);
        SC[lane] = beta; SC[64 + lane] = gc; SC[128 + lane] = __expf(gc); SC[192 + lane] = __expf(gl - gc);
        if (lane == 0) CD[ch] = __expf(gl);
    }
    __syncthreads();
    {
        const int gi = tid & 15, cbase = tid >> 4;
#pragma unroll
        for (int it = 0; it < 6; ++it) {
            const int kind = it >> 1, c = (it & 1) * 32 + cbase, col0 = kind * 512 + h * 128 + gi * 8;
            float y[8];
#pragma unroll
            for (int e = 0; e < 8; ++e) y[e] = 0.f;
#pragma unroll
            for (int j = 0; j < 4; ++j) {
                const int tt = n * 64 + c - 3 + j;
                if (tt >= 0) {
                    const v4u x = *(const GAS v4u*)(cols + (size_t)(b * SEQ + tt) * LDC + col0);
                    const f32x4 w0 = *(const GAS f32x4*)(A.in[17] + j * 1536 + col0), w1 = *(const GAS f32x4*)(A.in[17] + j * 1536 + col0 + 4);
                    y[0] += bflo(x.x) * w0.x; y[1] += bfhi(x.x) * w0.y; y[2] += bflo(x.y) * w0.z; y[3] += bfhi(x.y) * w0.w;
                    y[4] += bflo(x.z) * w1.x; y[5] += bfhi(x.z) * w1.y; y[6] += bflo(x.w) * w1.z; y[7] += bfhi(x.w) * w1.w;
                }
            }
            float ss = 0.f;
#pragma unroll
            for (int e = 0; e < 8; ++e) { y[e] = silu_f(y[e]); ss += y[e] * y[e]; }
            ss += __shfl_xor(ss, 1); ss += __shfl_xor(ss, 2); ss += __shfl_xor(ss, 4); ss += __shfl_xor(ss, 8);
            const float beta = SC[c], egc = SC[128 + c], ekd = SC[192 + c];
            if (kind == 0) {
                const float rn = 0.08838834764831845f / sqrtf(ss + 1e-6f);
                v4u o; o.x = cvtpk(y[0] * rn, y[1] * rn); o.y = cvtpk(y[2] * rn, y[3] * rn); o.z = cvtpk(y[4] * rn, y[5] * rn); o.w = cvtpk(y[6] * rn, y[7] * rn);
                *(LAS v4u*)(Qb + c * 136 + gi * 8) = o;
                const float rd = rn * egc;
                v4u d; d.x = cvtpk(y[0] * rd, y[1] * rd); d.y = cvtpk(y[2] * rd, y[3] * rd); d.z = cvtpk(y[4] * rd, y[5] * rd); d.w = cvtpk(y[6] * rd, y[7] * rd);
                { const int f = (c >> 4) * 4 + (gi >> 2), x0 = 8 * (gi & 3), g0 = (x0 & 15) >> 2, j0 = (x0 >> 4) * 4, rr = c & 15;
                  *(GAS v2u*)(G2 + ((f * 64 + 16 * g0 + rr) * 8 + j0)) = (v2u){d.x, d.y}; *(GAS v2u*)(G2 + ((f * 64 + 16 * (g0 + 1) + rr) * 8 + j0)) = (v2u){d.z, d.w}; }
            } else if (kind == 1) {
                const float rn = 1.0f / sqrtf(ss + 1e-6f);
                v4u o; o.x = cvtpk(y[0] * rn, y[1] * rn); o.y = cvtpk(y[2] * rn, y[3] * rn); o.z = cvtpk(y[4] * rn, y[5] * rn); o.w = cvtpk(y[6] * rn, y[7] * rn);
                *(LAS v4u*)(Kb + c * 136 + gi * 8) = o;
                const float rr = rn * beta * egc, rk = rn * ekd;
                LAS float* rp = RHS + c * 256 + 128 + gi * 8;
                *(LAS f32x4*)rp = (f32x4){y[0] * rr, y[1] * rr, y[2] * rr, y[3] * rr}; *(LAS f32x4*)(rp + 4) = (f32x4){y[4] * rr, y[5] * rr, y[6] * rr, y[7] * rr};
#pragma unroll
                for (int e = 0; e < 8; ++e) { const int x = c & 31, gg = (x & 15) >> 2, jj = (x >> 4) * 4 + (x & 3), f = 16 + (gi >> 1) * 2 + (c >> 5);
                    G1[(f * 64 + 16 * gg + 8 * (gi & 1) + e) * 8 + jj] = (bf16)f2bf(y[e] * rk); }
            } else {
                LAS float* rp = RHS + c * 256 + gi * 8;
                *(LAS f32x4*)rp = (f32x4){y[0] * beta, y[1] * beta, y[2] * beta, y[3] * beta}; *(LAS f32x4*)(rp + 4) = (f32x4){y[4] * beta, y[5] * beta, y[6] * beta, y[7] * beta};
            }
        }
    }
    __syncthreads();
    {
        const int kind = wave >> 2, mt = wave & 3, g = lane >> 4, rr = lane & 15;
        const LAS bf16* Am = kind ? Qb : Kb;
#pragma unroll
        for (int nt = 0; nt < 4; ++nt) {
            f32x4 acc = (f32x4){0.f, 0.f, 0.f, 0.f};
            if (nt <= mt) {
#pragma unroll
                for (int s = 0; s < 4; ++s) {
                    const bf16x8 a = *(const LAS bf16x8*)(Am + (16 * mt + rr) * 136 + 32 * s + 8 * g);
                    const bf16x8 bq = *(const LAS bf16x8*)(Kb + (16 * nt + rr) * 136 + 32 * s + 8 * g);
                    acc = __builtin_amdgcn_mfma_f32_16x16x32_bf16(a, bq, acc, 0, 0, 0);
                }
            }
            const int j = 16 * nt + rr; const float gcj = SC[64 + j];
#pragma unroll
            for (int r = 0; r < 4; ++r) {
                const int i = 16 * mt + 4 * g + r; const float dec = __expf(fminf(SC[64 + i] - gcj, 0.f));
                if (kind == 0) { Lm[i * 68 + j] = (i > j) ? acc[r] * SC[i] * dec : 0.f; }
                else { const int f = 16 + mt * 2 + (nt >> 1);
                    G2[(f * 64 + 16 * (rr >> 2) + 4 * g + r) * 8 + (nt & 1) * 4 + (rr & 3)] = (bf16)f2bf((i >= j) ? acc[r] * dec : 0.f); }
            }
        }
    }
    __syncthreads();
    if (tid < 256) {
        float x[64];
#pragma unroll
        for (int i = 0; i < 64; ++i) {
            float s = RHS[i * 256 + tid];
#pragma unroll
            for (int j = 0; j < i; ++j) s -= Lm[i * 68 + j] * x[j];
            x[i] = s;
            if ((i & 3) == 3) asm volatile("" ::: "memory");
        }
        if (tid < 128) {
            const int sl = tid >> 4, dl = tid & 15;
#pragma unroll
            for (int q = 0; q < 16; ++q) { const int mt = q >> 2, gq = q & 3; v2u o; o.x = cvtpk(x[4 * q], x[4 * q + 1]); o.y = cvtpk(x[4 * q + 2], x[4 * q + 3]);
                *(GAS v2u*)(UF + ((sl * 4 + mt) * 64 + 16 * gq + dl) * 4) = o; }
        } else {
            const int dk = tid - 128, sK = dk >> 5, xx = dk & 31, gg = (xx & 15) >> 2, jj = (xx >> 4) * 4 + (xx & 3);
#pragma unroll
            for (int i = 0; i < 64; ++i) G1[(((i >> 4) * 4 + sK) * 64 + 16 * gg + (i & 15)) * 8 + jj] = (bf16)f2bf(-x[i]);
        }
    }
    __syncthreads();
}

__device__ __forceinline__ bf16x8 pack_bfrag(const f32x4& t0, const f32x4& t1) {
    const v4u w = (v4u){cvtpk(t0[0], t0[1]), cvtpk(t0[2], t0[3]), cvtpk(t1[0], t1[1]), cvtpk(t1[2], t1[3])};
    return __builtin_bit_cast(bf16x8, w);
}
constexpr int SCAN_SLOT = 40960;
__device__ __forceinline__ unsigned char* shvn_frag(unsigned char* ws, int b, int n, int h, int f) { return ws + WS_BIG + (size_t)(b * SEQ + 64 * n + 16 * h + f / 3) * (LDC * 2) + (f % 3) * 1024; }
__device__ __forceinline__ void gdn_scan_wg(Frame& F, int b, int h, int half) {
    const int lane = F.lane, wave = F.wave;
    LAS unsigned char* ring = F.lds + RING_OFF;
    LAS float* cdt = (LAS float*)(F.lds + CDTAB_OFF);
    if (F.tid < NCH) cdt[F.tid] = ((const float*)(F.ws + WS_GCD))[(b * NCH + F.tid) * 4 + h];
    const unsigned char* g1b = F.ws + WS_G1 + (size_t)((b * NCH) * 4 + h) * 32768;
    const unsigned char* ufb = F.ws + WS_UF + (size_t)((b * NCH) * 4 + h) * 16384 + half * 8192;
#define SCAN_DMA(n_, slot_) do { const int hw_ = wave - 4; \
        _Pragma("unroll") for (int q_ = 0; q_ < 10; ++q_) { const int q = hw_ * 10 + q_; \
            const unsigned char* src = (q < 32) ? g1b + (size_t)(n_) * (4 * 32768) + q * 1024 : ufb + (size_t)(n_) * (4 * 16384) + (q - 32) * 1024; \
            __builtin_amdgcn_global_load_lds((const unsigned*)(src + lane * 16), (LAS unsigned*)(ring + (slot_) * SCAN_SLOT + q * 1024), 16, 0, 0); } } while (0)
    if (wave >= 4) { SCAN_DMA(0, 0); SCAN_DMA(1, 1); asm volatile("s_waitcnt vmcnt(10)" ::: "memory"); }
    asm volatile("s_waitcnt lgkmcnt(0)" ::: "memory"); __builtin_amdgcn_s_barrier(); asm volatile("" ::: "memory");
    if (wave >= 4) {
        int slot = 2;
        for (int n = 0; n < NCH; ++n) {
            if (n + 2 < NCH) { SCAN_DMA(n + 2, slot); asm volatile("s_waitcnt vmcnt(10)" ::: "memory"); } else { asm volatile("s_waitcnt vmcnt(0)" ::: "memory"); }
            slot = (slot == 2) ? 0 : slot + 1;
            __builtin_amdgcn_s_barrier(); asm volatile("" ::: "memory");
        }
    } else {
        const int sl = half * 4 + wave;
        f32x4 S[8];
#pragma unroll
        for (int t = 0; t < 8; ++t) S[t] = (f32x4){0.f, 0.f, 0.f, 0.f};
        int slot = 0;
        for (int n = 0; n < NCH; ++n) {
            const LAS unsigned char* sb = ring + slot * SCAN_SLOT + lane * 16;
            const float cd = cdt[n];
            bf16x8 Sb[4];
#pragma unroll
            for (int s = 0; s < 4; ++s) { Sb[s] = pack_bfrag(S[2 * s], S[2 * s + 1]); *(GAS bf16x8*)(shvn_frag(F.ws, b, n, h, sl * 4 + s) + lane * 16) = Sb[s]; }
            f32x4 vt[4];
#pragma unroll
            for (int mt = 0; mt < 4; ++mt) {
                const v2u u = *(const LAS v2u*)(ring + slot * SCAN_SLOT + 32768 + wave * 2048 + mt * 512 + lane * 8);
                vt[mt] = (f32x4){bflo(u.x), bfhi(u.x), bflo(u.y), bfhi(u.y)};
#pragma unroll
                for (int s = 0; s < 4; ++s) vt[mt] = __builtin_amdgcn_mfma_f32_16x16x32_bf16(*(const LAS bf16x8*)(sb + (mt * 4 + s) * 1024), Sb[s], vt[mt], 0, 0, 0);
            }
            bf16x8 vb[2];
            vb[0] = pack_bfrag(vt[0], vt[1]); vb[1] = pack_bfrag(vt[2], vt[3]);
            *(GAS bf16x8*)(shvn_frag(F.ws, b, n, h, 32 + sl * 2) + lane * 16) = vb[0]; *(GAS bf16x8*)(shvn_frag(F.ws, b, n, h, 32 + sl * 2 + 1) + lane * 16) = vb[1];
#pragma unroll
            for (int t = 0; t < 8; ++t) {
                S[t] = S[t] * cd;
#pragma unroll
                for (int s = 0; s < 2; ++s) S[t] = __builtin_amdgcn_mfma_f32_16x16x32_bf16(*(const LAS bf16x8*)(sb + 16384 + (t * 2 + s) * 1024), vb[s], S[t], 0, 0, 0);
            }
            slot = (slot == 2) ? 0 : slot + 1;
            asm volatile("s_waitcnt lgkmcnt(0)" ::: "memory"); __builtin_amdgcn_s_barrier(); asm volatile("" ::: "memory");
        }
        const int g = lane >> 4, rr = lane & 15;
        float* so = F.out + O_GDNP + (size_t)(b * 4 + h) * 128 * 128 + 16 * sl + rr;
#pragma unroll
        for (int t = 0; t < 8; ++t)
#pragma unroll
            for (int r = 0; r < 4; ++r) so[(size_t)(16 * t + 4 * g + r) * 128] = S[t][r];
    }
#undef SCAN_DMA
}
__device__ __forceinline__ void gdn_out_phase(Frame& F, const Args& A) {
    bf16* mix = (bf16*)(F.ws + WS_MIXIN);
    const int lane = F.lane, sl = F.wave, g = lane >> 4, rr = lane & 15, tid = F.tid;
    LAS unsigned char* L = F.lds + RING_OFF;
    const int NIT = NB * NCH * 4;
#define OUT_DMA(it_, k_) do { const int ch_ = (it_); const int h_ = ch_ & 3, n_ = (ch_ >> 2) % NCH, b_ = ch_ / (4 * NCH); \
        const unsigned char* g2_ = F.ws + WS_G2 + (size_t)ch_ * 24576 + lane * 16; \
        _Pragma("unroll") for (int i_ = 0; i_ < 3; ++i_) __builtin_amdgcn_global_load_lds((const unsigned*)(g2_ + (sl * 3 + i_) * 1024), (LAS unsigned*)(L + (k_) * 24576 + (sl * 3 + i_) * 1024), 16, 0, 0); \
        _Pragma("unroll") for (int i_ = 0; i_ < 2; ++i_) { const int p_ = sl * 2 + i_; \
            const unsigned char* z_ = F.ws + WS_BIG + (size_t)(b_ * SEQ + n_ * 64 + 4 * p_ + g) * (LDC * 2) + (C_Z + h_ * 128) * 2 + rr * 16; \
            __builtin_amdgcn_global_load_lds((const unsigned*)z_, (LAS unsigned*)(L + 49152 + (k_) * 16384 + p_ * 1024), 16, 0, 0); } } while (0)
    int it = blockIdx.x, k = 0;
    if (it < NIT) OUT_DMA(it, 0);
    for (; it < NIT; it += F.G, k ^= 1) {
        const int h = it & 3, n = (it >> 2) % NCH, b = it / (4 * NCH);
        bf16x8 Sb[4], vb[2];
#pragma unroll
        for (int s = 0; s < 4; ++s) Sb[s] = *(const GAS bf16x8*)(shvn_frag(F.ws, b, n, h, sl * 4 + s) + lane * 16);
#pragma unroll
        for (int s = 0; s < 2; ++s) vb[s] = *(const GAS bf16x8*)(shvn_frag(F.ws, b, n, h, 32 + sl * 2 + s) + lane * 16);
        const float gain = A.in[20][16 * sl + rr];
        asm volatile("s_waitcnt vmcnt(0)" ::: "memory");
        __builtin_amdgcn_s_barrier(); asm volatile("" ::: "memory");
        if (it + F.G < NIT) { OUT_DMA(it + F.G, k ^ 1); }
        const LAS unsigned char* g2 = L + k * 24576 + lane * 16;
        f32x4 ot[4];
#pragma unroll
        for (int mt = 0; mt < 4; ++mt) {
            ot[mt] = (f32x4){0.f, 0.f, 0.f, 0.f};
#pragma unroll
            for (int s = 0; s < 4; ++s) ot[mt] = __builtin_amdgcn_mfma_f32_16x16x32_bf16(*(const LAS bf16x8*)(g2 + (mt * 4 + s) * 1024), Sb[s], ot[mt], 0, 0, 0);
#pragma unroll
            for (int s = 0; s < 2; ++s) ot[mt] = __builtin_amdgcn_mfma_f32_16x16x32_bf16(*(const LAS bf16x8*)(g2 + (16 + mt * 2 + s) * 1024), vb[s], ot[mt], 0, 0, 0);
        }
        LAS float* ssq = (LAS float*)(L + 81920 + k * 2048);
#pragma unroll
        for (int mt = 0; mt < 4; ++mt)
#pragma unroll
            for (int r = 0; r < 4; ++r) { float q = ot[mt][r] * ot[mt][r]; q += __shfl_xor(q, 1); q += __shfl_xor(q, 2); q += __shfl_xor(q, 4); q += __shfl_xor(q, 8);
                if (rr == 0) ssq[sl * 64 + 16 * mt + 4 * g + r] = q; }
        asm volatile("s_waitcnt lgkmcnt(0)" ::: "memory"); __builtin_amdgcn_s_barrier(); asm volatile("" ::: "memory");
        LAS bf16* zt = (LAS bf16*)(L + 49152 + k * 16384);
#pragma unroll
        for (int mt = 0; mt < 4; ++mt)
#pragma unroll
            for (int r = 0; r < 4; ++r) { const int c = 16 * mt + 4 * g + r;
                const float tot = ((ssq[c] + ssq[64 + c]) + (ssq[128 + c] + ssq[192 + c])) + ((ssq[256 + c] + ssq[320 + c]) + (ssq[384 + c] + ssq[448 + c]));
                const float rn = 1.0f / sqrtf(tot * (1.f / 128.f) + EPS);
                LAS bf16* zp = zt + c * 128 + 16 * sl + rr; const float zz = bf2f(*zp);
                *zp = (bf16)f2bf(ot[mt][r] * rn * gain * silu_f(zz)); }
        asm volatile("s_waitcnt lgkmcnt(0)" ::: "memory"); __builtin_amdgcn_s_barrier(); asm volatile("" ::: "memory");
        const int r0 = b * SEQ + n * 64;
#pragma unroll
        for (int i = 0; i < 2; ++i) { const int idx = tid + 512 * i, row = idx >> 4, c16 = idx & 15;
            *(GAS v4u*)(mix + (size_t)(r0 + row) * D + h * 128 + c16 * 8) = *(const LAS v4u*)(zt + row * 128 + c16 * 8); }
    }
    asm volatile("s_waitcnt vmcnt(0) lgkmcnt(0)" ::: "memory"); __builtin_amdgcn_s_barrier(); asm volatile("" ::: "memory");
#undef OUT_DMA
}
__device__ __forceinline__ void swa_mfma_unit(Frame& F, const Args& A, int b, int kh, int qb) {
    const bf16* cols = (const bf16*)(F.ws + WS_BIG); bf16* mix = (bf16*)(F.ws + WS_MIXIN);
    LAS bf16* Kl = (LAS bf16*)(F.lds + RING_OFF);
    LAS bf16* VT = (LAS bf16*)(F.lds + RING_OFF + 36864);
    LAS float* BT = (LAS float*)(F.lds + RING_OFF + 70656);
    const int tid = F.tid, lane = F.lane, wave = F.wave, gl = lane >> 4, rr = lane & 15;
    const int r0 = b * SEQ + qb * 128;
#pragma unroll
    for (int i = 0; i < 4; ++i) {
        const int idx = tid + 512 * i, key = idx >> 3, c8 = idx & 7, p = (qb - 1) * 128 + key;
        v4u kx = (v4u){0, 0, 0, 0}, vx = (v4u){0, 0, 0, 0};
        if (p >= 0) { const bf16* src = cols + (size_t)(b * SEQ + p) * LDC + kh * 64 + c8 * 8; kx = *(const GAS v4u*)(src + C_KS); vx = *(const GAS v4u*)(src + C_VS); }
        *(LAS v4u*)(Kl + key * 72 + c8 * 8) = kx;
        LAS bf16* vt = VT + (c8 * 8) * 264 + key;
        vt[0] = (bf16)(vx.x & 0xffff); vt[264] = (bf16)(vx.x >> 16); vt[2 * 264] = (bf16)(vx.y & 0xffff); vt[3 * 264] = (bf16)(vx.y >> 16);
        vt[4 * 264] = (bf16)(vx.z & 0xffff); vt[5 * 264] = (bf16)(vx.z >> 16); vt[6 * 264] = (bf16)(vx.w & 0xffff); vt[7 * 264] = (bf16)(vx.w >> 16);
    }
    { const int g = tid >> 7, dist = tid & 127; BT[tid] = A.in[8][t5_bucket(dist) * 8 + kh * 4 + g]; }
    __syncthreads();
    const int g = wave >> 1, qh = wave & 1;
    const float sink = A.in[21][kh * 4 + g];
    const LAS float* bt = BT + g * 128;
#pragma unroll 1
    for (int qt = 0; qt < 4; ++qt) {
        const int qrow = r0 + 64 * qh + 16 * qt + rr, qidx = 128 + 64 * qh + 16 * qt + rr, kt0 = 4 * qh + qt;
        const bf16* qp = cols + (size_t)qrow * LDC + C_QS + (kh * 4 + g) * 64 + 8 * gl;
        const bf16x8 qf0 = __builtin_bit_cast(bf16x8, *(const GAS v4u*)qp), qf1 = __builtin_bit_cast(bf16x8, *(const GAS v4u*)(qp + 32));
        f32x4 sc[10];
        float mx = sink;
#pragma unroll
        for (int t = 0; t < 10; ++t) {
            const int kt = kt0 + t, ktc = kt < 15 ? kt : 15;
            const LAS bf16* kp = Kl + (16 * ktc + rr) * 72 + 8 * gl;
            f32x4 acc = (f32x4){0.f, 0.f, 0.f, 0.f};
            acc = __builtin_amdgcn_mfma_f32_16x16x32_bf16(*(const LAS bf16x8*)kp, qf0, acc, 0, 0, 0);
            acc = __builtin_amdgcn_mfma_f32_16x16x32_bf16(*(const LAS bf16x8*)(kp + 32), qf1, acc, 0, 0, 0);
#pragma unroll
            for (int r = 0; r < 4; ++r) {
                const int kk = 16 * kt + 4 * gl + r, dist = qidx - kk;
                const bool valid = dist >= 0 && dist < 128 && (qb > 0 || kk >= 128);
                const float v = valid ? acc[r] * 0.125f + bt[dist & 127] : -INFINITY;
                sc[t][r] = v; mx = fmaxf(mx, v);
            }
        }
        mx = fmaxf(mx, __shfl_xor(mx, 16)); mx = fmaxf(mx, __shfl_xor(mx, 32));
        float sum = 0.f;
#pragma unroll
        for (int t = 0; t < 10; ++t)
#pragma unroll
            for (int r = 0; r < 4; ++r) { const float p = __expf(sc[t][r] - mx); sc[t][r] = p; sum += p; }
        sum += __shfl_xor(sum, 16); sum += __shfl_xor(sum, 32);
        const float inv = 1.0f / (sum + __expf(sink - mx));
        f32x4 o[4];
#pragma unroll
        for (int dt = 0; dt < 4; ++dt) o[dt] = (f32x4){0.f, 0.f, 0.f, 0.f};
#pragma unroll
        for (int s5 = 0; s5 < 5; ++s5) {
            const bf16x8 pb = pack_bfrag(sc[2 * s5], sc[2 * s5 + 1]);
            const int ka = kt0 + 2 * s5, kb = ka + 1, kac = ka < 15 ? ka : 15, kbc = kb < 15 ? kb : 15;
#pragma unroll
            for (int dt = 0; dt < 4; ++dt) {
                const LAS bf16* vp = VT + (16 * dt + rr) * 264 + 4 * gl;
                const v2u va = *(const LAS v2u*)(vp + 16 * kac), vb = *(const LAS v2u*)(vp + 16 * kbc);
                const v4u vw = (v4u){va.x, va.y, vb.x, vb.y};
                o[dt] = __builtin_amdgcn_mfma_f32_16x16x32_bf16(__builtin_bit_cast(bf16x8, vw), pb, o[dt], 0, 0, 0);
            }
        }
        bf16* op = mix + (size_t)qrow * D + 512 + (kh * 4 + g) * 64 + 4 * gl;
#pragma unroll
        for (int dt = 0; dt < 4; ++dt) { v2u w; w.x = cvtpk(o[dt][0] * inv, o[dt][1] * inv); w.y = cvtpk(o[dt][2] * inv, o[dt][3] * inv); *(GAS v2u*)(op + 16 * dt) = w; }
    }
    __syncthreads();
}
__device__ __forceinline__ void gdn_prep_phase(Frame& F, const Args& A) {
    for (int it = blockIdx.x; it < NB * NCH * 4; it += F.G) { const int h = it & 3, n = (it >> 2) % NCH, b = it / (4 * NCH); gdn_prep_item(F, A, b, n, h); }
    { const bf16* cols = (const bf16*)(F.ws + WS_BIG); const int gt = blockIdx.x * (NWAVES * 64) + F.tid, NT = F.G * NWAVES * 64;
      for (int i = gt; i < 2 * 3 * 1536; i += NT) { const int c = i % 1536, r = (i / 1536) % 3, b = i / (3 * 1536); F.out[O_CONVP + i] = bf2f(cols[(size_t)(b * SEQ + SEQ - 3 + r) * LDC + c]); } }
}
__device__ __forceinline__ void mixers_phase(Frame& F, const Args& A) {
    const bf16* cols = (const bf16*)(F.ws + WS_BIG);
    const int bx = (int)blockIdx.x;
    if (bx < 16) { for (int r_ = 0; r_ < (DBG_TWICE == 61 ? 2 : 1); ++r_) { gdn_scan_wg(F, (bx & 7) >> 2, bx & 3, bx >> 3); __syncthreads(); } return; }
    const int wg = bx - 16, NWG = F.G - 16;
    for (int r_ = 0; r_ < (DBG_TWICE == 62 ? 2 : 1); ++r_)
    for (int it = wg; it < DECB * 4; it += NWG) gdn_naive_item(F, A, false, it >> 2, it & 3);
    { LAS float* qs = (LAS float*)(F.lds + RING_OFF + F.wave * 16384); LAS float* ps = qs + 256;
      const int gw = wg * NWAVES + F.wave, NGW = NWG * NWAVES;
      for (int it = gw; it < MS * 2; it += NGW) swa_item(F, A, MP + (it >> 1), it & 1, qs, ps); }
    __syncthreads();
    for (int r_ = 0; r_ < (DBG_TWICE == 63 ? 2 : 1); ++r_)
    for (int it = wg; it < NB * 2 * (SEQ / 128); it += NWG) swa_mfma_unit(F, A, it >> 7, (it >> 6) & 1, it & 63);
    { const int gt = wg * (NWAVES * 64) + F.tid, NT = NWG * NWAVES * 64;
      for (int i = gt; i < 2 * 128 * 128; i += NT) { const int c = i % 128, r = (i / 128) % 128, b = i / (128 * 128); const size_t ro = (size_t)(b * SEQ + SEQ - 128 + r) * LDC;
          F.out[O_KP + i] = bf2f(cols[ro + C_KS + c]); F.out[O_VP + i] = bf2f(cols[ro + C_VS + c]); }
      for (int i = gt; i < DECB * 3 * 1536; i += NT) { const int c = i % 1536, r = (i / 1536) % 3, s = i / (3 * 1536); F.out[O_CONVS + i] = bf2f(cols[(size_t)(MP + s * DECT + 1 + r) * LDC + c]); }
      for (int i = gt; i < DECB * 128 * 128; i += NT) { const int c = i % 128, j = (i / 128) % 128, s = i / (128 * 128);
          if (j < 124) { F.out[O_KS + i] = A.in[4][(size_t)(s * 128 + j + 4) * 128 + c]; F.out[O_VS + i] = A.in[5][(size_t)(s * 128 + j + 4) * 128 + c]; }
          else { const size_t ro = (size_t)(MP + s * DECT + (j - 124)) * LDC; F.out[O_KS + i] = bf2f(cols[ro + C_KS + c]); F.out[O_VS + i] = bf2f(cols[ro + C_VS + c]); } }
    }
}
__global__ void __launch_bounds__(NWAVES * 64, 2) mk_fwd(Args args) {
    extern __shared__ __attribute__((aligned(16))) unsigned char lds[];
    Frame F;
    F.lds = (LAS unsigned char*)lds;
    F.MISC = (volatile LAS unsigned*)(F.lds + MISC_OFF);
    F.tid = threadIdx.x; F.lane = F.tid & 63; F.wave = __builtin_amdgcn_readfirstlane(F.tid >> 6);
    F.G = gridDim.x; { const int bx = blockIdx.x; F.vcu = (F.G % 8 == 0) ? (bx % 8) * (F.G / 8) + bx / 8 : bx; }
    F.ws = args.ws; F.out = args.out; F.ctl = (gu32*)(args.ws + WS_CTL);
    for (int u = F.tid; u < (LDS_BYTES - LDSCTL_OFF) / 4; u += NWAVES * 64) ((LAS unsigned*)(F.lds + LDSCTL_OFF))[u] = 0u;
    __syncthreads();
    const int lo = args.ph_lo, hi = args.ph_hi;
    XcdBarrier bar; bar.bar = (unsigned*)(F.ctl + CW_BAR); bar.x = 0; bar.st = nullptr;
    if (hi - lo > 1 || DBG_STOP < 99) bar = xcd_barrier_post((unsigned*)(F.ctl + CW_BAR), F.MISC + 8);
#ifndef PH_MASK
#define PH_MASK 0xffffffffu
#endif
#define IN(k) (((PH_MASK >> (k)) & 1u) && lo <= (k) && (k) < hi && (k) <= DBG_STOP)
#define SEAM(k) do { if (IN(k) && IN((k) + 1)) xcd_barrier(bar); } while (0)
    bf16* HB = (bf16*)(F.ws + WS_HBUF); bf16* BIG = (bf16*)(F.ws + WS_BIG); bf16* TMP = (bf16*)(F.ws + WS_TMP); bf16* MIX = (bf16*)(F.ws + WS_MIXIN); bf16* PB = (bf16*)(F.ws + WS_PBUF);
    const int bx = (int)blockIdx.x;

    if (IN(0)) { for (int _r = 0; _r < ((DBG_TWICE == 0) ? 2 : 1); ++_r) { p0_prologue(F, args); if (DBG_TWICE == 0 && _r == 0) xcd_barrier(bar); } } SEAM(0);
    if (IN(1)) { for (int _r = 0; _r < ((DBG_TWICE == 1) ? 2 : 1); ++_r) { pg8::Gemm g{HB, (const bf16*)(F.ws + WS_WGU1), M, 2 * FF, D}; pg8::StaticOrder S; S.init(M, 2 * FF, F.G, bx); pg8::EpiGen<1> E{BIG, FF, nullptr};
        pg8::gemm_phase<pg8::EpiGen<1>, pg8::StaticOrder, true, true>(F.lds + RING_OFF, g, S, E); if (DBG_TWICE == 1 && _r == 0) xcd_barrier(bar); } } SEAM(1);
    if (IN(2)) { for (int _r = 0; _r < ((DBG_TWICE == 2) ? 2 : 1); ++_r) { pg8::Gemm g{BIG, (const bf16*)(F.ws + WS_WD1), M, D, FF}; pg8::StaticOrder S; S.init(M, D, F.G, bx); pg8::EpiGen<0> E{TMP, D, nullptr};
        pg8::gemm_phase<pg8::EpiGen<0>, pg8::StaticOrder, true, true>(F.lds + RING_OFF, g, S, E); if (DBG_TWICE == 2 && _r == 0) xcd_barrier(bar); } } SEAM(2);
    if (IN(3)) { for (int _r = 0; _r < ((DBG_TWICE == 3) ? 2 : 1); ++_r) { resid_pass<1, true>(F, args.in[0], args.in[1], TMP, 0.5f, args.in[10], args.in[14], HB); if (DBG_TWICE == 3 && _r == 0) xcd_barrier(bar); } } SEAM(3);
    if (IN(4)) { for (int _r = 0; _r < ((DBG_TWICE == 4) ? 2 : 1); ++_r) { pg8::Gemm g{HB, (const bf16*)(F.ws + WS_WIN), M, LDC, D}; pg8::StaticOrder S; S.init(M, LDC, F.G, bx); pg8::EpiGen<0> E{BIG, LDC, nullptr};
        pg8::gemm_phase<pg8::EpiGen<0>, pg8::StaticOrder, true, true>(F.lds + RING_OFF, g, S, E); if (DBG_TWICE == 4 && _r == 0) xcd_barrier(bar); } } SEAM(4);
    if (IN(5)) { for (int _r = 0; _r < ((DBG_TWICE == 5) ? 2 : 1); ++_r) { gdn_prep_phase(F, args); if (DBG_TWICE == 5 && _r == 0) xcd_barrier(bar); } } SEAM(5);
    if (IN(6)) { for (int _r = 0; _r < ((DBG_TWICE == 6) ? 2 : 1); ++_r) { mixers_phase(F, args); if (DBG_TWICE == 6 && _r == 0) xcd_barrier(bar); } } SEAM(6);
    if (IN(7)) { for (int _r = 0; _r < ((DBG_TWICE == 7) ? 2 : 1); ++_r) { gdn_out_phase(F, args); if (DBG_TWICE == 7 && _r == 0) xcd_barrier(bar); } } SEAM(7);
    if (IN(8)) { for (int _r = 0; _r < ((DBG_TWICE == 8) ? 2 : 1); ++_r) { pg8::Gemm g{MIX, (const bf16*)(F.ws + WS_WOUT), M, D, D}; pg8::StaticOrder S; S.init(M, D, F.G, bx); pg8::EpiGen<0> E{TMP, D, nullptr};
        pg8::gemm_phase<pg8::EpiGen<0>, pg8::StaticOrder, true, true>(F.lds + RING_OFF, g, S, E); if (DBG_TWICE == 8 && _r == 0) xcd_barrier(bar); } } SEAM(8);
    if (IN(9)) { for (int _r = 0; _r < ((DBG_TWICE == 9) ? 2 : 1); ++_r) { resid_pass<1, false>(F, nullptr, nullptr, TMP, 1.0f, args.in[15], args.in[23], HB); if (DBG_TWICE == 9 && _r == 0) xcd_barrier(bar); } } SEAM(9);
    if (IN(10)) { for (int _r = 0; _r < ((DBG_TWICE == 10) ? 2 : 1); ++_r) { pg8::Gemm g{HB, (const bf16*)(F.ws + WS_WGU2), M, 2 * FF, D}; pg8::StaticOrder S; S.init(M, 2 * FF, F.G, bx); pg8::EpiGen<1> E{BIG, FF, nullptr};
        pg8::gemm_phase<pg8::EpiGen<1>, pg8::StaticOrder, true, true>(F.lds + RING_OFF, g, S, E); if (DBG_TWICE == 10 && _r == 0) xcd_barrier(bar); } } SEAM(10);
    if (IN(11)) { for (int _r = 0; _r < ((DBG_TWICE == 11) ? 2 : 1); ++_r) { pg8::Gemm g{BIG, (const bf16*)(F.ws + WS_WD2), M, D, FF}; pg8::StaticOrder S; S.init(M, D, F.G, bx); pg8::EpiGen<0> E{TMP, D, nullptr};
        pg8::gemm_phase<pg8::EpiGen<0>, pg8::StaticOrder, true, true>(F.lds + RING_OFF, g, S, E); if (DBG_TWICE == 11 && _r == 0) xcd_barrier(bar); } } SEAM(11);
    if (IN(12)) { for (int _r = 0; _r < ((DBG_TWICE == 12) ? 2 : 1); ++_r) { resid_pass<2, false>(F, nullptr, nullptr, TMP, 0.5f, args.in[24], nullptr, HB); if (DBG_TWICE == 12 && _r == 0) xcd_barrier(bar); } } SEAM(12);
    if (IN(13)) { for (int _r = 0; _r < ((DBG_TWICE == 13) ? 2 : 1); ++_r) { pg8::Gemm g{HB, (const bf16*)(F.ws + WS_WPG), M, D, D}; pg8::StaticOrder S; S.init(M, D, F.G, bx); pg8::EpiGen<2> E{TMP, D, nullptr};
        pg8::gemm_phase<pg8::EpiGen<2>, pg8::StaticOrder, true, true>(F.lds + RING_OFF, g, S, E); if (DBG_TWICE == 13 && _r == 0) xcd_barrier(bar); } } SEAM(13);
    if (IN(14)) { for (int _r = 0; _r < ((DBG_TWICE == 14) ? 2 : 1); ++_r) { pg8::Gemm g{PB, (const bf16*)(F.ws + WS_WPP), M, D, PLE}; pg8::StaticOrder S; S.init(M, D, F.G, bx); pg8::EpiGen<3> E{MIX, D, TMP};
        pg8::gemm_phase<pg8::EpiGen<3>, pg8::StaticOrder, true, true>(F.lds + RING_OFF, g, S, E); if (DBG_TWICE == 14 && _r == 0) xcd_barrier(bar); } } SEAM(14);
    if (IN(15)) { resid_pass<0, false>(F, nullptr, nullptr, MIX, 1.0f, args.in[30], nullptr, nullptr); }

#if DBG_STOP < 99
    xcd_barrier(bar);
    { const bf16* dsrc = (const bf16*)(F.ws + DBG_BUF); const size_t gt = (size_t)blockIdx.x * (NWAVES * 64) + F.tid, NT = (size_t)F.G * NWAVES * 64;
      if (DBG_LD > 0) for (size_t i = gt; i < (size_t)M * D; i += NT) F.out[i] = bf2f(dsrc[(i / D) * DBG_LD + (i % D)]);
      for (size_t i = (size_t)M * D + gt; i < O_END; i += NT) F.out[i] = 0.f; }
#endif
#undef IN
#undef SEAM
}

extern "C" void kernel_launch(void* const* d_in, const int* in_sizes, int n_in, void* d_out, int out_size, void* d_ws, size_t ws_size, hipStream_t stream) {
    static int grid = 0;
    if (grid == 0) {
        if (n_in != 31 || (size_t)out_size != O_END || ws_size < WS_END + 4096) { fprintf(stderr, "kernel_launch: unexpected shapes: n_in %d out %d ws %zu\n", n_in, out_size, ws_size); grid = -1; return; }
        int dev = 0, cus = 0, per_cu = 0;
        if (hipGetDevice(&dev) != hipSuccess || hipDeviceGetAttribute(&cus, hipDeviceAttributeMultiprocessorCount, dev) != hipSuccess) { grid = -1; return; }
        if (hipFuncSetAttribute((const void*)mk_fwd, hipFuncAttributeMaxDynamicSharedMemorySize, LDS_BYTES) != hipSuccess) { fprintf(stderr, "kernel_launch: hipFuncSetAttribute failed\n"); grid = -1; return; }
        if (hipOccupancyMaxActiveBlocksPerMultiprocessor(&per_cu, (const void*)mk_fwd, NWAVES * 64, LDS_BYTES) != hipSuccess || per_cu < 1) { fprintf(stderr, "kernel_launch: occupancy query says %d\n", per_cu); }
        (void)hipGetLastError();
        grid = cus;
    }
    if (grid < 0) return;
    (void)hipMemsetAsync((char*)d_ws + WS_CTL, 0, CTL_ZERO_BYTES, stream);
    Args a{};
    for (int i = 0; i < 31; ++i) a.in[i] = (const float*)d_in[i];
    a.out = (float*)d_out; a.ws = (unsigned char*)d_ws;
    constexpr int NL = MK_N_LAUNCHES;
    for (int li = 0; li < NL; ++li) {
        a.ph_lo = (NL == 1) ? 0 : li; a.ph_hi = (NL == 1) ? N_PHASES : li + 1;
        hipLaunchKernelGGL(mk_fwd, dim3(grid), dim3(NWAVES * 64), LDS_BYTES, stream, a);
    }
}
```
